# Optimizing an MI355X kernel written in HIP

```python
import jax, jax.numpy as jnp
from jax import lax
import numpy as np

D_MODEL = 1024
BATCH = 8
SEQ = 8192
DEPTH = 1

CHUNK = 128
MLP_GROUPS = 8
MLP_GROUP_DIM = 128
MLP_WIDTH = MLP_GROUPS * MLP_GROUP_DIM
WINDOW = 128
N_Q_HEADS = 16
N_KV_HEADS = 2
HEAD_DIM = 64
Q_PER_KV = N_Q_HEADS // N_KV_HEADS
ATTN_WIDTH = N_Q_HEADS * HEAD_DIM
KV_WIDTH = N_KV_HEADS * HEAD_DIM
N_BRANCHES = 2
SPLITS = (2 * MLP_WIDTH,
          2 * MLP_WIDTH + ATTN_WIDTH,
          2 * MLP_WIDTH + ATTN_WIDTH + KV_WIDTH,
          2 * MLP_WIDTH + ATTN_WIDTH + 2 * KV_WIDTH)
IN_COLS = 2 * MLP_WIDTH + ATTN_WIDTH + 2 * KV_WIDTH + N_BRANCHES * D_MODEL
PEER_HEADS = 8
PEER_NKEYS = 128
PEER_EXPERTS = PEER_NKEYS * PEER_NKEYS
PEER_TOPK = 16
PEER_QDIM = 256
PEER_HALF = PEER_QDIM // 2
PEER_BLOCK = 128
ALPHA = (2.0 * DEPTH) ** 0.25
BETA = (8.0 * DEPTH) ** -0.25
LN_EPS = 1e-5
N_MOD = 6

kernel_name = 'hybrid_gmlp_swa_peer_block'


def layer_norm(x, g, b):
    xf = x.astype(jnp.float32)
    mu = jnp.mean(xf, axis=-1, keepdims=True)
    var = jnp.mean(jnp.square(xf - mu), axis=-1, keepdims=True)
    y = (xf - mu) * lax.rsqrt(var + LN_EPS)
    return (y * g.astype(jnp.float32) + b.astype(jnp.float32)).astype(x.dtype)


def gmlp_spatial_gating(z_uv, lnv_g, lnv_b, w_s, b_s):
    B, S, _ = z_uv.shape
    z = jax.nn.gelu(z_uv, approximate=False)
    u, v = jnp.split(z, 2, axis=-1)
    v = layer_norm(v, lnv_g, lnv_b)
    v = v.reshape(B, S // CHUNK, CHUNK, MLP_GROUPS, MLP_GROUP_DIM)
    causal = jnp.tril(jnp.ones((CHUNK, CHUNK), dtype=bool))
    w = jnp.where(causal[None], w_s, jnp.zeros_like(w_s))
    mixed = jnp.einsum('gts,bcsgd->bctgd', w, v) + b_s.T[:, :, None]
    return u * mixed.reshape(B, S, MLP_WIDTH)


def sliding_window_attention(q, k, v, sinks):
    B, S, _ = q.shape
    nb = S // WINDOW
    q = q.reshape(B, nb, WINDOW, N_KV_HEADS, Q_PER_KV, HEAD_DIM)
    k = k.reshape(B, nb, WINDOW, N_KV_HEADS, HEAD_DIM)
    v = v.reshape(B, nb, WINDOW, N_KV_HEADS, HEAD_DIM)

    def with_prev(t):
        prev = jnp.pad(t, ((0, 0), (1, 0), (0, 0), (0, 0), (0, 0)))[:, :-1]
        return jnp.concatenate([prev, t], axis=2)

    kb, vb = with_prev(k), with_prev(v)
    scores = jnp.einsum('bnqhgd,bnkhd->bnhgqk', q, kb).astype(jnp.float32) * (HEAD_DIM ** -0.5)
    qi = jnp.arange(WINDOW)[:, None] + WINDOW
    ki = jnp.arange(2 * WINDOW)[None, :]
    band = (ki <= qi) & (ki > qi - WINDOW)
    has_prev = jnp.arange(nb)[:, None, None] > 0
    valid = band[None] & (has_prev | (ki[None] >= WINDOW))
    scores = jnp.where(valid[None, :, None, None], scores, jnp.finfo(jnp.float32).min)
    sink = sinks.astype(jnp.float32).reshape(N_KV_HEADS, Q_PER_KV)[None, None, :, :, None, None]
    sink = jnp.broadcast_to(sink, scores.shape[:-1] + (1,))
    probs = jax.nn.softmax(jnp.concatenate([scores, sink], axis=-1), axis=-1)[..., :-1]
    out = jnp.einsum('bnhgqk,bnkhd->bnqhgd', probs.astype(vb.dtype), vb)
    return out.reshape(B, S, ATTN_WIDTH)


def peer_layer(xt, w_pq, sub_k1, sub_k2, peer_u, peer_v):
    T, D = xt.shape

    def block(xb):
        q = (xb @ w_pq).reshape(-1, PEER_HEADS, PEER_QDIM)
        q1, q2 = q[..., :PEER_HALF], q[..., PEER_HALF:]
        s1 = jnp.einsum('thd,hkd->thk', q1, sub_k1).astype(jnp.float32)
        s2 = jnp.einsum('thd,hkd->thk', q2, sub_k2).astype(jnp.float32)
        v1, i1 = lax.top_k(s1, PEER_TOPK)
        v2, i2 = lax.top_k(s2, PEER_TOPK)
        cand = (v1[..., :, None] + v2[..., None, :]).reshape(-1, PEER_HEADS, PEER_TOPK * PEER_TOPK)
        sc, ci = lax.top_k(cand, PEER_TOPK)
        e = (jnp.take_along_axis(i1, ci // PEER_TOPK, axis=-1) * PEER_NKEYS
             + jnp.take_along_axis(i2, ci % PEER_TOPK, axis=-1))
        g = jax.nn.softmax(sc, axis=-1)
        act = jax.nn.gelu(jnp.einsum('thkd,td->thk', peer_u[e], xb).astype(jnp.float32),
                          approximate=False)
        return jnp.einsum('thk,thkd->td', (g * act).astype(xb.dtype), peer_v[e])

    out = lax.map(block, xt.reshape(T // PEER_BLOCK, PEER_BLOCK, D))
    return out.reshape(T, D)


def setup_inputs(seed: int = 0) -> dict:
    key = jax.random.key(seed)
    ks = jax.random.split(key, 24)
    nrm = lambda k, shape, s: jax.random.normal(k, shape, jnp.float32) * s
    L, D = DEPTH, D_MODEL
    return {
        'x': nrm(ks[0], (BATCH, SEQ, D), 1.0),
        'c': nrm(ks[1], (BATCH, D), 1.0),
        'w_ada': nrm(ks[2], (L, D, N_MOD * D), 0.1 * D ** -0.5),
        'b_ada': nrm(ks[3], (L, N_MOD * D), 0.02),
        'w_in': nrm(ks[4], (L, D, IN_COLS), D ** -0.5),
        'lnv_g': 1.0 + nrm(ks[5], (L, MLP_WIDTH), 0.02),
        'lnv_b': nrm(ks[6], (L, MLP_WIDTH), 0.02),
        'w_spatial': nrm(ks[7], (L, MLP_GROUPS, CHUNK, CHUNK), CHUNK ** -0.5),
        'b_spatial': 1.0 + nrm(ks[8], (L, MLP_GROUPS, CHUNK), 0.1),
        'attn_sinks': nrm(ks[9], (L, N_Q_HEADS), 0.5),
        'w_proj_a': nrm(ks[10], (L, MLP_WIDTH, D), BETA * MLP_WIDTH ** -0.5),
        'w_proj_b': nrm(ks[11], (L, ATTN_WIDTH, D), BETA * ATTN_WIDTH ** -0.5),
        'w_out': nrm(ks[12], (L, D, D), BETA * D ** -0.5),
        'ln1_g': 1.0 + nrm(ks[13], (L, D), 0.02),
        'ln1_b': nrm(ks[14], (L, D), 0.02),
        'w_pq': nrm(ks[15], (L, D, PEER_HEADS * PEER_QDIM), D ** -0.5),
        'sub_keys1': nrm(ks[16], (L, PEER_HEADS, PEER_NKEYS, PEER_HALF), PEER_HALF ** -0.5),
        'sub_keys2': nrm(ks[17], (L, PEER_HEADS, PEER_NKEYS, PEER_HALF), PEER_HALF ** -0.5),
        'peer_u': nrm(ks[18], (L, PEER_EXPERTS, D), D ** -0.5),
        'peer_v': nrm(ks[19], (L, PEER_EXPERTS, D), BETA * PEER_HEADS ** -0.5),
        'ln2_g': 1.0 + nrm(ks[20], (L, D), 0.02),
        'ln2_b': nrm(ks[21], (L, D), 0.02),
    }


def reference(x, c, w_ada, b_ada, w_in, lnv_g, lnv_b, w_spatial, b_spatial, attn_sinks,
              w_proj_a, w_proj_b, w_out, ln1_g, ln1_b, w_pq, sub_keys1, sub_keys2,
              peer_u, peer_v, ln2_g, ln2_b):
    B, S, D = x.shape
    for l in range(DEPTH):
        mod = jax.nn.silu(c) @ w_ada[l] + b_ada[l]
        sh1, sc1, gt1, sh2, sc2, gt2 = [m[:, None, :] for m in jnp.split(mod, N_MOD, axis=-1)]

        h = x * (1.0 + sc1) + sh1
        proj = h @ w_in[l]
        z_uv, q, k, v, gates = jnp.split(proj, SPLITS, axis=-1)
        a = gmlp_spatial_gating(z_uv, lnv_g[l], lnv_b[l], w_spatial[l], b_spatial[l])
        o = sliding_window_attention(q, k, v, attn_sinks[l])
        g_a, g_b = jnp.split(jax.nn.sigmoid(gates), N_BRANCHES, axis=-1)
        merged = g_a * (a @ w_proj_a[l]) + g_b * (o @ w_proj_b[l])
        mix = merged @ w_out[l]
        x = layer_norm(ALPHA * x + (1.0 + gt1) * mix, ln1_g[l], ln1_b[l])

        h = x * (1.0 + sc2) + sh2
        f = peer_layer(h.reshape(B * S, D), w_pq[l], sub_keys1[l], sub_keys2[l],
                       peer_u[l], peer_v[l]).reshape(B, S, D)
        x = layer_norm(ALPHA * x + (1.0 + gt2) * f, ln2_g[l], ln2_b[l])
    return x
```

```cpp
#include <hip/hip_runtime.h>
#include <hip/hip_cooperative_groups.h>
#include <cstdio>
namespace cg = cooperative_groups;

#ifndef ONE_LAUNCH
#define ONE_LAUNCH 1
#endif

#define LAS __attribute__((address_space(3)))
typedef unsigned short bf16_t;
typedef short bf16x8 __attribute__((ext_vector_type(8)));
typedef float f32x4 __attribute__((ext_vector_type(4)));
typedef float f32x2 __attribute__((ext_vector_type(2)));
typedef unsigned u32x4 __attribute__((ext_vector_type(4)));
typedef unsigned u32x2 __attribute__((ext_vector_type(2)));

constexpr int T = 65536, D = 1024, SEQ = 8192;
constexpr size_t MiB = 1ull << 20;
constexpr size_t WS_ZUV = 0;
constexpr size_t WS_QKV = 256 * MiB;
constexpr size_t WS_GATES = 416 * MiB;
constexpr size_t WS_AO = 672 * MiB;
constexpr size_t WS_IDX = WS_AO;
constexpr size_t WS_WGT = WS_AO + 32 * MiB;
constexpr size_t WS_WIN = 928 * MiB;
constexpr size_t WS_WAB = WS_WIN + (size_t)5376 * 1024 * 2;
constexpr size_t WS_WOUT = WS_WAB + 4 * MiB;
constexpr size_t WS_WPQ = WS_WOUT + 2 * MiB;
constexpr size_t WS_SK = WS_WPQ + 4 * MiB;
constexpr size_t WS_WSP = WS_SK + 512 * 1024;
constexpr size_t WS_PU = WS_WSP + 256 * 1024;
constexpr size_t WS_PV = WS_PU + 32 * MiB;
constexpr size_t WS_MOD = WS_PV + 32 * MiB;
constexpr size_t WS_STATS = WS_MOD + 256 * 1024;
constexpr size_t WS_BAR = WS_STATS + 512 * 1024;
constexpr size_t WS_END = WS_BAR + 16 * 1024;

constexpr float ALPHA = 1.18920711500272f;
constexpr float LN_EPS = 1e-5f;

__device__ __forceinline__ unsigned cvt_pk_bf16(float lo, float hi) { unsigned r; asm volatile("v_cvt_pk_bf16_f32 %0, %1, %2" : "=v"(r) : "v"(lo), "v"(hi)); return r; }
__device__ __forceinline__ float bf_lo(unsigned w) { return __uint_as_float(w << 16); }
__device__ __forceinline__ float bf_hi(unsigned w) { return __uint_as_float(w & 0xffff0000u); }
__device__ __forceinline__ float wave_sum(float v) {
#pragma unroll
    for (int o = 32; o >= 1; o >>= 1) v += __shfl_xor(v, o);
    return v;
}

namespace pg8 {
constexpr int BM = 256, BK = 64, HALF = 128, HTB = HALF * BK * 2, STAGE_BYTES = 8 * HTB, NXCD = 8, WGM = 8;
__host__ __device__ __forceinline__ int lds_byte(int r, int c) { const int st = (r >> 4) * 2 + (c >> 5), rr = r & 15, cc = c & 31, ob = rr * 64 + cc * 2; return st * 1024 + (ob ^ (((ob >> 9) & 1) << 5)); }
__host__ __device__ __forceinline__ void stage_rc(int b, int& R, int& C) { const int st = b / 1024, sb = b % 1024, swz = sb ^ (((sb >> 9) & 1) << 5); R = (st >> 1) * 16 + swz / 64; C = (st & 1) * 32 + (swz % 64) / 2; }
__host__ __device__ __forceinline__ int perm32(int rho) { const int n = rho >> 4, i = rho & 15; return 8 * (i >> 2) + 4 * n + (i & 3); }
struct Unit { int pm, pn; };
struct Gemm { const bf16_t* A; const bf16_t* Bt; int M, N, K; };
struct StaticOrder {
    int nM, nN, nwg, G, c;
    __host__ __device__ void init(int M, int N, int G_, int c_) { nM = M / BM; nN = N / BM; nwg = nM * nN; G = G_; c = c_; }
    __host__ __device__ bool next(int i, Unit& u) const {
        const long L = (long)i * G + c; if (L >= nwg) return false;
        int wgid = (int)L; { const int q = nwg / NXCD, r = nwg % NXCD, xcd = wgid % NXCD, off = wgid / NXCD; wgid = (xcd < r ? xcd * (q + 1) : r * (q + 1) + (xcd - r) * q) + off; }
        const int nig = WGM * nN, gid = wgid / nig, fm = gid * WGM, gsz = (nM - fm) < WGM ? (nM - fm) : WGM;
        u.pm = fm + ((wgid % nig) % gsz); u.pn = (wgid % nig) / gsz; return true;
    }
};
struct PairOrder {
    StaticOrder so;
    __host__ __device__ bool next(int i, Unit& u) const { Unit t; if (!so.next(i >> 1, t)) return false; u.pm = t.pm + (i & 1) * 256; u.pn = t.pn + (i & 1) * 4; return true; }
};
__device__ __forceinline__ f32x2 gelu_pk(f32x2 v) {
    const f32x2 av = __builtin_elementwise_abs(v), d = av * 0.2316418882f + 1.0f;
    f32x2 t; t.x = __builtin_amdgcn_rcpf(d.x); t.y = __builtin_amdgcn_rcpf(d.y);
    f32x2 q = t * 0.5307027145f + (-0.7265760135f); q = q * t + 0.7107068705f; q = q * t + (-0.142248368f); q = q * t + 0.127414796f; q = q * t;
    const f32x2 s = (v * v) * (-0.72134752044f);
    f32x2 e; e.x = __builtin_amdgcn_exp2f(s.x); e.y = __builtin_amdgcn_exp2f(s.y);
    const f32x2 m = v * (q * e), r = v - m;
    f32x2 o; o.x = v.x < 0.f ? m.x : r.x; o.y = v.y < 0.f ? m.y : r.y; return o;
}

template <class Epi, class Sched>
__device__ __forceinline__ void gemm_phase(LAS unsigned char* lds, const Gemm g, const Sched& S, const Epi& E) {
    const int tid = threadIdx.x, wid = __builtin_amdgcn_readfirstlane(tid >> 6), lane = tid & 63, wr = wid >> 2, wc = wid & 3, fr = lane & 15, fq = lane >> 4;
    const int K = g.K, nt = K / BK;
    unsigned voffA[2], voffB[2];
#pragma unroll
    for (int i = 0; i < 2; ++i) { int R, C; stage_rc(tid * 16 + i * 8192, R, C); const int Rb = Epi::PERM ? ((R & ~31) + perm32(R & 31)) : R;
        voffA[i] = (unsigned)(R * K + C) * 2u; voffB[i] = (unsigned)(Rb * K + C) * 2u; }
    const size_t kstep = (size_t)(BK * 2);
    const size_t hstep = (size_t)HALF * K * 2;
    const size_t tstep = 2 * hstep;
    const unsigned ldsw = (unsigned)wid * 1024u;
    const int aoff = lds_byte(wr * 64 + fr, fq * 8), boff = lds_byte(wc * 32 + fr, fq * 8);
#define PG8_SA(b, h) (((b) * 2 + (h)) * HTB)
#define PG8_SB(b, h) ((4 + (b) * 2 + (h)) * HTB)
#define PG8_STAGE(bufoff, gbase, voff) do { _Pragma("unroll") for (int _i = 0; _i < 2; ++_i) \
        __builtin_amdgcn_global_load_lds((const unsigned*)((const char*)(gbase) + (voff)[_i]), (LAS unsigned*)(lds + (bufoff) + ldsw + _i * 8192), 16, 0, 0); } while (0)
#define PG8_LDA(dst, b, h) do { _Pragma("unroll") for (int m = 0; m < 4; ++m) _Pragma("unroll") for (int k = 0; k < 2; ++k) dst[m][k] = *(const LAS bf16x8*)(lds + PG8_SA(b, h) + aoff + m * 2048 + k * 1024); } while (0)
#define PG8_LDB(dst, b, h) do { _Pragma("unroll") for (int n = 0; n < 2; ++n) _Pragma("unroll") for (int k = 0; k < 2; ++k) dst[n][k] = *(const LAS bf16x8*)(lds + PG8_SB(b, h) + boff + n * 2048 + k * 1024); } while (0)
#define PG8_MMA(ai, bj, At, Bt) do { __builtin_amdgcn_s_setprio(1); _Pragma("unroll") for (int m = 0; m < 4; ++m) _Pragma("unroll") for (int n = 0; n < 2; ++n) _Pragma("unroll") for (int k = 0; k < 2; ++k) \
        acc[ai][bj][m][n] = __builtin_amdgcn_mfma_f32_16x16x32_bf16(Bt[n][k], At[m][k], acc[ai][bj][m][n], 0, 0, 0); __builtin_amdgcn_s_setprio(0); } while (0)
#define PG8_WAIT_V(n) asm volatile("s_waitcnt vmcnt(" #n ")" ::: "memory")
#define PG8_WAIT_L(n) asm volatile("s_waitcnt lgkmcnt(" #n ")" ::: "memory")
#define PG8_BAR __builtin_amdgcn_s_barrier()
#define PG8_SCHED __builtin_amdgcn_sched_barrier(0)
    Unit cur, nxt; int ui = 0;
    if (!S.next(0, cur)) return;
    f32x4 acc[2][2][4][2];
#pragma unroll
    for (int a = 0; a < 2; ++a)
#pragma unroll
        for (int b = 0; b < 2; ++b)
#pragma unroll
            for (int m = 0; m < 4; ++m)
#pragma unroll
                for (int n = 0; n < 2; ++n) acc[a][b][m][n] = (f32x4){0.f, 0.f, 0.f, 0.f};
    bf16x8 At[4][2], B0[2][2], B1[2][2];
    const char* cA = (const char*)g.A + (size_t)cur.pm * tstep; const char* cB = (const char*)g.Bt + (size_t)cur.pn * tstep;
    PG8_STAGE(PG8_SB(0, 0), cB, voffB); PG8_STAGE(PG8_SA(0, 0), cA, voffA); PG8_STAGE(PG8_SB(0, 1), cB + hstep, voffB); PG8_STAGE(PG8_SA(0, 1), cA + hstep, voffA);
    if (wr == 1) PG8_BAR;
    PG8_WAIT_V(4); PG8_BAR;
    PG8_STAGE(PG8_SB(1, 0), cB + kstep, voffB); PG8_STAGE(PG8_SA(1, 0), cA + kstep, voffA); PG8_STAGE(PG8_SB(1, 1), cB + hstep + kstep, voffB);
    PG8_WAIT_V(6); PG8_BAR;
    for (;;) {
        const bool has_next = S.next(ui + 1, nxt);
        const char* nA = has_next ? (const char*)g.A + (size_t)nxt.pm * tstep : cA; const char* nB = has_next ? (const char*)g.Bt + (size_t)nxt.pn * tstep : cB;
        for (int t = 0; t < nt; t += 2) {
            const bool last = (t == nt - 2);
            const char* a1 = cA + (size_t)(t + 1) * kstep;
            const char* a2 = last ? nA : cA + (size_t)(t + 2) * kstep; const char* b2 = last ? nB : cB + (size_t)(t + 2) * kstep;
            const char* a3 = a2 + kstep; const char* b3 = b2 + kstep;
            PG8_LDB(B0, 0, 0); PG8_SCHED; PG8_LDA(At, 0, 0); PG8_STAGE(PG8_SA(1, 1), a1 + hstep, voffA);
            PG8_WAIT_L(8); PG8_BAR; PG8_WAIT_L(0); PG8_MMA(0, 0, At, B0); PG8_BAR; PG8_SCHED;
            PG8_LDB(B1, 0, 1); PG8_STAGE(PG8_SB(0, 0), b2, voffB);
            PG8_BAR; PG8_WAIT_L(0); PG8_MMA(0, 1, At, B1); PG8_BAR;
            PG8_LDA(At, 0, 1); PG8_STAGE(PG8_SA(0, 0), a2, voffA);
            PG8_BAR; PG8_WAIT_L(0); PG8_MMA(1, 0, At, B0); PG8_BAR; PG8_SCHED;
            PG8_STAGE(PG8_SB(0, 1), b2 + hstep, voffB);
            PG8_WAIT_V(6); PG8_BAR; PG8_MMA(1, 1, At, B1); PG8_BAR;
            PG8_LDB(B0, 1, 0); PG8_SCHED; PG8_LDA(At, 1, 0); PG8_STAGE(PG8_SA(0, 1), a2 + hstep, voffA);
            PG8_WAIT_L(8); PG8_BAR; PG8_WAIT_L(0); PG8_MMA(0, 0, At, B0); PG8_BAR; PG8_SCHED;
            PG8_LDB(B1, 1, 1); PG8_STAGE(PG8_SB(1, 0), b3, voffB);
            PG8_BAR; PG8_WAIT_L(0); PG8_MMA(0, 1, At, B1); PG8_BAR;
            PG8_LDA(At, 1, 1); PG8_STAGE(PG8_SA(1, 0), a3, voffA);
            PG8_BAR; PG8_WAIT_L(0); PG8_MMA(1, 0, At, B0); PG8_BAR; PG8_SCHED;
            PG8_STAGE(PG8_SB(1, 1), b3 + hstep, voffB);
            PG8_WAIT_V(6); PG8_BAR; PG8_MMA(1, 1, At, B1); PG8_BAR;
        }
        const bool keep_acc = E(acc, cur, wr, wc, fr, fq);
        if (!has_next) break;
        if (!keep_acc)
#pragma unroll
        for (int a = 0; a < 2; ++a)
#pragma unroll
            for (int b = 0; b < 2; ++b)
#pragma unroll
                for (int m = 0; m < 4; ++m)
#pragma unroll
                    for (int n = 0; n < 2; ++n) acc[a][b][m][n] = (f32x4){0.f, 0.f, 0.f, 0.f};
        cur = nxt; cA = nA; cB = nB; ++ui;
    }
    PG8_WAIT_V(0);
    if (wr == 0) PG8_BAR;
    PG8_BAR;
#undef PG8_SA
#undef PG8_SB
#undef PG8_STAGE
#undef PG8_LDA
#undef PG8_LDB
#undef PG8_MMA
#undef PG8_WAIT_V
#undef PG8_WAIT_L
#undef PG8_BAR
#undef PG8_SCHED
}
}

struct EpiProj {
    static constexpr bool PERM = true;
    bf16_t* zuv; bf16_t* qkv; bf16_t* gates;
    __device__ __forceinline__ bool operator()(f32x4 (&acc)[2][2][4][2], const pg8::Unit& u, int wr, int wc, int fr, int fq) const {
        const int row0 = u.pm * 256 + wr * 64 + fr;
        int mode, ldc, colt; bf16_t* base;
        if (u.pn < 8) { mode = 1; base = zuv; ldc = 2048; colt = u.pn * 256; }
        else if (u.pn < 13) { mode = 0; base = qkv; ldc = 1280; colt = (u.pn - 8) * 256; }
        else { mode = 2; base = gates; ldc = 2048; colt = (u.pn - 13) * 256; }
        const int col0 = colt + wc * 32 + 8 * fq;
#pragma unroll
        for (int ai = 0; ai < 2; ++ai)
#pragma unroll
            for (int m = 0; m < 4; ++m) { bf16_t* rowp = base + (size_t)(row0 + ai * 128 + m * 16) * ldc + col0;
#pragma unroll
                for (int bj = 0; bj < 2; ++bj) { f32x4 v0 = acc[ai][bj][m][0], v1 = acc[ai][bj][m][1];
                    if (mode == 1) { f32x2 a = pg8::gelu_pk((f32x2){v0[0], v0[1]}), b = pg8::gelu_pk((f32x2){v0[2], v0[3]}), c = pg8::gelu_pk((f32x2){v1[0], v1[1]}), d = pg8::gelu_pk((f32x2){v1[2], v1[3]});
                        v0 = (f32x4){a.x, a.y, b.x, b.y}; v1 = (f32x4){c.x, c.y, d.x, d.y}; }
                    else if (mode == 2) {
#pragma unroll
                        for (int j = 0; j < 4; ++j) { v0[j] = __builtin_amdgcn_rcpf(1.0f + __expf(-v0[j])); v1[j] = __builtin_amdgcn_rcpf(1.0f + __expf(-v1[j])); } }
                    u32x4 w; w.x = cvt_pk_bf16(v0[0], v0[1]); w.y = cvt_pk_bf16(v0[2], v0[3]); w.z = cvt_pk_bf16(v1[0], v1[1]); w.w = cvt_pk_bf16(v1[2], v1[3]);
                    *(u32x4*)(rowp + bj * 128) = w; } }
        return false;
    }
};
struct EpiMerge {
    static constexpr bool PERM = true;
    const bf16_t* gates; bf16_t* merged;
    __device__ __forceinline__ bool operator()(f32x4 (&acc)[2][2][4][2], const pg8::Unit& u, int wr, int wc, int fr, int fq) const {
        const int which = u.pm >> 8, pm = u.pm & 255, pn = u.pn & 3;
        const int row0 = pm * 256 + wr * 64 + fr, col0 = pn * 256 + wc * 32 + 8 * fq;
#pragma unroll
        for (int ai = 0; ai < 2; ++ai)
#pragma unroll
            for (int m = 0; m < 4; ++m) { const size_t row = (size_t)(row0 + ai * 128 + m * 16);
#pragma unroll
                for (int bj = 0; bj < 2; ++bj) { const int col = col0 + bj * 128;
                    const u32x4 gb = *(const u32x4*)(gates + row * 2048 + 1024 + col);
                    float gbf[8] = {bf_lo(gb.x), bf_hi(gb.x), bf_lo(gb.y), bf_hi(gb.y), bf_lo(gb.z), bf_hi(gb.z), bf_lo(gb.w), bf_hi(gb.w)};
#pragma unroll
                    for (int j = 0; j < 8; ++j) gbf[j] = fmaxf(gbf[j], 1e-6f);
                    if (which == 0) {
                        const u32x4 ga = *(const u32x4*)(gates + row * 2048 + col);
                        const float gaf[8] = {bf_lo(ga.x), bf_hi(ga.x), bf_lo(ga.y), bf_hi(ga.y), bf_lo(ga.z), bf_hi(ga.z), bf_lo(ga.w), bf_hi(ga.w)};
#pragma unroll
                        for (int j = 0; j < 4; ++j) { acc[ai][bj][m][0][j] *= gaf[j] * __builtin_amdgcn_rcpf(gbf[j]); acc[ai][bj][m][1][j] *= gaf[4 + j] * __builtin_amdgcn_rcpf(gbf[4 + j]); }
                    } else {
                        f32x4 v0 = acc[ai][bj][m][0], v1 = acc[ai][bj][m][1];
#pragma unroll
                        for (int j = 0; j < 4; ++j) { v0[j] *= gbf[j]; v1[j] *= gbf[4 + j]; }
                        u32x4 w; w.x = cvt_pk_bf16(v0[0], v0[1]); w.y = cvt_pk_bf16(v0[2], v0[3]); w.z = cvt_pk_bf16(v1[0], v1[1]); w.w = cvt_pk_bf16(v1[2], v1[3]);
                        *(u32x4*)(merged + row * 1024 + col) = w; } } }
        return which == 0;
    }
};
struct EpiY1 {
    static constexpr bool PERM = true;
    const float* x; const float* mod; bf16_t* y1;
    __device__ __forceinline__ bool operator()(f32x4 (&acc)[2][2][4][2], const pg8::Unit& u, int wr, int wc, int fr, int fq) const {
        const int row0 = u.pm * 256 + wr * 64 + fr, col0 = u.pn * 256 + wc * 32 + 8 * fq;
        const int b = (u.pm * 256) >> 13;
        f32x4 gt[2][2];
#pragma unroll
        for (int bj = 0; bj < 2; ++bj)
#pragma unroll
            for (int n = 0; n < 2; ++n) gt[bj][n] = *(const f32x4*)(mod + b * 6144 + 2048 + col0 + bj * 128 + n * 4) + 1.0f;
#pragma unroll
        for (int ai = 0; ai < 2; ++ai)
#pragma unroll
            for (int m = 0; m < 4; ++m) { const size_t off = (size_t)(row0 + ai * 128 + m * 16) * 1024 + col0;
#pragma unroll
                for (int bj = 0; bj < 2; ++bj) { const f32x4 x0 = *(const f32x4*)(x + off + bj * 128), x1 = *(const f32x4*)(x + off + bj * 128 + 4);
                    const f32x4 v0 = x0 * ALPHA + gt[bj][0] * acc[ai][bj][m][0], v1 = x1 * ALPHA + gt[bj][1] * acc[ai][bj][m][1];
                    u32x4 w; w.x = cvt_pk_bf16(v0[0], v0[1]); w.y = cvt_pk_bf16(v0[2], v0[3]); w.z = cvt_pk_bf16(v1[0], v1[1]); w.w = cvt_pk_bf16(v1[2], v1[3]);
                    *(u32x4*)(y1 + off + bj * 128) = w; } }
        return false;
    }
};
struct EpiQ {
    static constexpr bool PERM = true;
    bf16_t* q;
    __device__ __forceinline__ bool operator()(f32x4 (&acc)[2][2][4][2], const pg8::Unit& u, int wr, int wc, int fr, int fq) const {
        const int row0 = u.pm * 256 + wr * 64 + fr, col0 = u.pn * 256 + wc * 32 + 8 * fq;
#pragma unroll
        for (int ai = 0; ai < 2; ++ai)
#pragma unroll
            for (int m = 0; m < 4; ++m) { bf16_t* rowp = q + (size_t)(row0 + ai * 128 + m * 16) * 2048 + col0;
#pragma unroll
                for (int bj = 0; bj < 2; ++bj) { const f32x4 v0 = acc[ai][bj][m][0], v1 = acc[ai][bj][m][1];
                    u32x4 w; w.x = cvt_pk_bf16(v0[0], v0[1]); w.y = cvt_pk_bf16(v0[2], v0[3]); w.z = cvt_pk_bf16(v1[0], v1[1]); w.w = cvt_pk_bf16(v1[2], v1[3]);
                    *(u32x4*)(rowp + bj * 128) = w; } }
        return false;
    }
};

struct Args { const float* in[22]; float* out; unsigned char* ws; int ph_lo, ph_hi; };

constexpr float PU_SCALE = 48.0f, PV_SCALE = 7.0f;
typedef float f32x32 __attribute__((ext_vector_type(32)));
typedef _Float16 f16x32 __attribute__((ext_vector_type(32)));
typedef unsigned u32x6 __attribute__((ext_vector_type(6)));
typedef u32x4 u32x4_a8 __attribute__((aligned(8)));
__device__ __forceinline__ void cvt32_fp6(const float* src, unsigned char* dst, size_t i, float sc) {
    f16x32 hv;
#pragma unroll
    for (int q = 0; q < 8; ++q) { const f32x4 a = *(const f32x4*)(src + i * 32 + q * 4) * sc;
        hv[q * 4 + 0] = (_Float16)a[0]; hv[q * 4 + 1] = (_Float16)a[1]; hv[q * 4 + 2] = (_Float16)a[2]; hv[q * 4 + 3] = (_Float16)a[3]; }
    const u32x6 r = __builtin_amdgcn_cvt_scalef32_pk32_fp6_f16(hv, 1.0f);
    unsigned char* q = dst + i * 24;
    *(u32x4_a8*)q = (u32x4){r[0], r[1], r[2], r[3]}; *(u32x2*)(q + 16) = (u32x2){r[4], r[5]};
}
__device__ __forceinline__ void cvt8(const float* src, bf16_t* dst, size_t i) {
    const f32x4 a = *(const f32x4*)(src + i * 8), b = *(const f32x4*)(src + i * 8 + 4);
    u32x4 w; w.x = cvt_pk_bf16(a[0], a[1]); w.y = cvt_pk_bf16(a[2], a[3]); w.z = cvt_pk_bf16(b[0], b[1]); w.w = cvt_pk_bf16(b[2], b[3]);
    *(u32x4*)(dst + i * 8) = w;
}
__device__ __forceinline__ void transpose_tile(const float* W, bf16_t* Wt, int K, int N, int k0, int n0, float* tile  ) {
    const int tid = threadIdx.x;
    __syncthreads();
#pragma unroll
    for (int p = 0; p < 2; ++p) { const int kk = (tid >> 4) + p * 32, n4 = tid & 15;
        const f32x4 v = *(const f32x4*)(W + (size_t)(k0 + kk) * N + n0 + n4 * 4);
        tile[kk * 65 + n4 * 4 + 0] = v[0]; tile[kk * 65 + n4 * 4 + 1] = v[1]; tile[kk * 65 + n4 * 4 + 2] = v[2]; tile[kk * 65 + n4 * 4 + 3] = v[3]; }
    __syncthreads();
    const int nn = tid >> 3, k8 = tid & 7;
    float f[8];
#pragma unroll
    for (int j = 0; j < 8; ++j) f[j] = tile[(k8 * 8 + j) * 65 + nn];
    u32x4 w; w.x = cvt_pk_bf16(f[0], f[1]); w.y = cvt_pk_bf16(f[2], f[3]); w.z = cvt_pk_bf16(f[4], f[5]); w.w = cvt_pk_bf16(f[6], f[7]);
    *(u32x4*)(Wt + (size_t)(n0 + nn) * K + k0 + k8 * 8) = w;
}
__device__ __forceinline__ void p_prep(const Args& a, unsigned char* lds) {
    unsigned char* ws = a.ws;
    const int tid = threadIdx.x, G = gridDim.x, bid = blockIdx.x;
    const size_t gtid = (size_t)bid * 512 + tid, gstride = (size_t)G * 512;
    {
        float* sc = (float*)lds;
        float* part = (float*)(lds + 32768);
        const float* c = a.in[1]; const float* w_ada = a.in[2]; const float* b_ada = a.in[3];
        float* mod = (float*)(ws + WS_MOD);
        for (int i = tid; i < 8192; i += 512) { const float v = c[i]; sc[i] = v / (1.0f + __expf(-v)); }
        __syncthreads();
        for (int task = bid; task < 256; task += G) {
            const int cg3 = tid & 7, ks = tid >> 3, n0 = task * 24 + cg3 * 3;
            float acc[8][3];
#pragma unroll
            for (int b = 0; b < 8; ++b) { acc[b][0] = 0.f; acc[b][1] = 0.f; acc[b][2] = 0.f; }
#pragma unroll 4
            for (int kk = 0; kk < 16; ++kk) { const int k = ks * 16 + kk;
                const float w0 = w_ada[(size_t)k * 6144 + n0], w1 = w_ada[(size_t)k * 6144 + n0 + 1], w2 = w_ada[(size_t)k * 6144 + n0 + 2];
#pragma unroll
                for (int b = 0; b < 8; ++b) { const float s = sc[b * 1024 + k]; acc[b][0] += s * w0; acc[b][1] += s * w1; acc[b][2] += s * w2; } }
            __syncthreads();
#pragma unroll
            for (int b = 0; b < 8; ++b)
#pragma unroll
                for (int j = 0; j < 3; ++j) part[(ks * 8 + b) * 24 + cg3 * 3 + j] = acc[b][j];
            __syncthreads();
            if (tid < 192) { const int b = tid / 24, cc = tid % 24; float s = 0.f;
                for (int k2 = 0; k2 < 64; ++k2) s += part[(k2 * 8 + b) * 24 + cc];
                mod[b * 6144 + task * 24 + cc] = s + b_ada[task * 24 + cc]; }
        }
        __syncthreads();
    }
    {
        float* tile = (float*)lds;
        for (int tl = bid; tl < 2624; tl += G) {
            const float* W; bf16_t* Wt; int N, idx;
            if (tl < 1344) { W = a.in[4]; Wt = (bf16_t*)(ws + WS_WIN); N = 5376; idx = tl; }
            else if (tl < 1600) { W = a.in[10]; Wt = (bf16_t*)(ws + WS_WAB); N = 1024; idx = tl - 1344; }
            else if (tl < 1856) { W = a.in[11]; Wt = (bf16_t*)(ws + WS_WAB) + (size_t)1024 * 1024; N = 1024; idx = tl - 1600; }
            else if (tl < 2112) { W = a.in[12]; Wt = (bf16_t*)(ws + WS_WOUT); N = 1024; idx = tl - 1856; }
            else { W = a.in[15]; Wt = (bf16_t*)(ws + WS_WPQ); N = 2048; idx = tl - 2112; }
            const int nN = N / 64, kt = idx / nN, ntile = idx % nN;
            transpose_tile(W, Wt, 1024, N, kt * 64, ntile * 64, tile);
        }
        __syncthreads();
    }
    {
        const float* pu = a.in[18]; const float* pv = a.in[19];
        bf16_t* PU = (bf16_t*)(ws + WS_PU); bf16_t* PV = (bf16_t*)(ws + WS_PV);
        const size_t n32 = (size_t)16384 * 1024 / 32;
        for (size_t i = gtid; i < n32; i += gstride) { cvt32_fp6(pu, (unsigned char*)PU, i, PU_SCALE); cvt32_fp6(pv, (unsigned char*)PV, i, PV_SCALE); }
        bf16_t* SK = (bf16_t*)(ws + WS_SK);
        for (size_t i = gtid; i < 131072 / 8; i += gstride) { cvt8(a.in[16], SK, i); cvt8(a.in[17], SK + 131072, i); }
        bf16_t* WSP = (bf16_t*)(ws + WS_WSP); const float* wsp = a.in[7];
        for (size_t i = gtid; i < 131072 / 8; i += gstride) {
            const int e0 = (int)i * 8, s0 = e0 & 127, t = (e0 >> 7) & 127;
            f32x4 x0 = *(const f32x4*)(wsp + e0), x1 = *(const f32x4*)(wsp + e0 + 4);
#pragma unroll
            for (int j = 0; j < 4; ++j) { if (s0 + j > t) x0[j] = 0.f; if (s0 + 4 + j > t) x1[j] = 0.f; }
            u32x4 w; w.x = cvt_pk_bf16(x0[0], x0[1]); w.y = cvt_pk_bf16(x0[2], x0[3]); w.z = cvt_pk_bf16(x1[0], x1[1]); w.w = cvt_pk_bf16(x1[2], x1[3]);
            *(u32x4*)(WSP + e0) = w;
        }
    }
}

__device__ __forceinline__ void p_h(const Args& a) {
    const float* x = a.in[0]; const float* mod = (const float*)(a.ws + WS_MOD); bf16_t* H = (bf16_t*)(a.ws + WS_AO);
    const size_t gtid = (size_t)blockIdx.x * 512 + threadIdx.x, gstride = (size_t)gridDim.x * 512;
    for (size_t i = gtid; i < (size_t)T * D / 8; i += gstride) {
        const size_t e = i * 8; const int col = (int)(e & 1023), b = (int)(e >> 23);
        const float* mp = mod + b * 6144;
        const f32x4 x0 = *(const f32x4*)(x + e), x1 = *(const f32x4*)(x + e + 4);
        const f32x4 s0 = *(const f32x4*)(mp + 1024 + col), s1 = *(const f32x4*)(mp + 1024 + col + 4);
        const f32x4 h0 = *(const f32x4*)(mp + col), h1 = *(const f32x4*)(mp + col + 4);
        const f32x4 r0 = x0 * (s0 + 1.0f) + h0, r1 = x1 * (s1 + 1.0f) + h1;
        u32x4 w; w.x = cvt_pk_bf16(r0[0], r0[1]); w.y = cvt_pk_bf16(r0[2], r0[3]); w.z = cvt_pk_bf16(r1[0], r1[1]); w.w = cvt_pk_bf16(r1[2], r1[3]);
        *(u32x4*)(H + e) = w;
    }
}

__device__ __forceinline__ void p_gmlp(const Args& a, unsigned char* lds) {
    const bf16_t* ZUV = (const bf16_t*)(a.ws + WS_ZUV); bf16_t* AO = (bf16_t*)(a.ws + WS_AO);
    const bf16_t* WSP = (const bf16_t*)(a.ws + WS_WSP);
    const float* lnv_g = a.in[5]; const float* lnv_b = a.in[6]; const float* b_sp = a.in[8];
    const int tid = threadIdx.x, lane = tid & 63, wid = tid >> 6, g4 = lane >> 4, l15 = lane & 15;
    constexpr int VS = 272;
    unsigned char* VnT = lds;
    float* stats = (float*)(lds + 36864);
    for (int ch = blockIdx.x; ch < 512; ch += gridDim.x) {
        const size_t t0 = (size_t)ch * 128;
        __syncthreads();
#pragma unroll 1
        for (int r8 = 0; r8 < 16; r8 += 8) {
            u32x4 p0[8], p1[8];
#pragma unroll
            for (int r = 0; r < 8; ++r) { const bf16_t* vp = ZUV + (t0 + wid * 16 + r8 + r) * 2048 + 1024; p0[r] = *(const u32x4*)(vp + lane * 8); p1[r] = *(const u32x4*)(vp + 512 + lane * 8); }
#pragma unroll
            for (int r = 0; r < 8; ++r) { const int s = wid * 16 + r8 + r;
                float f[16] = {bf_lo(p0[r].x), bf_hi(p0[r].x), bf_lo(p0[r].y), bf_hi(p0[r].y), bf_lo(p0[r].z), bf_hi(p0[r].z), bf_lo(p0[r].w), bf_hi(p0[r].w),
                               bf_lo(p1[r].x), bf_hi(p1[r].x), bf_lo(p1[r].y), bf_hi(p1[r].y), bf_lo(p1[r].z), bf_hi(p1[r].z), bf_lo(p1[r].w), bf_hi(p1[r].w)};
                float sm = 0.f;
#pragma unroll
                for (int j = 0; j < 16; ++j) sm += f[j];
                const float mu = wave_sum(sm) * (1.0f / 1024.0f);
                float q = 0.f;
#pragma unroll
                for (int j = 0; j < 16; ++j) { const float d = f[j] - mu; q += d * d; }
                const float var = wave_sum(q) * (1.0f / 1024.0f);
                if (lane == 0) { stats[s * 2] = mu; stats[s * 2 + 1] = rsqrtf(var + LN_EPS); }
            }
        }
        __syncthreads();
        u32x4 pvn[4];
#pragma unroll
        for (int i = 0; i < 4; ++i) pvn[i] = *(const u32x4*)(ZUV + (t0 + (tid >> 4) + 32 * i) * 2048 + 1024 + (tid & 15) * 8);
        for (int g = 0; g < 8; ++g) {
            { const int d8 = tid & 15;
              u32x4 pv[4];
#pragma unroll
              for (int i = 0; i < 4; ++i) pv[i] = pvn[i];
              const f32x4 ga = *(const f32x4*)(lnv_g + g * 128 + d8 * 8), gb = *(const f32x4*)(lnv_g + g * 128 + d8 * 8 + 4);
              const f32x4 ba = *(const f32x4*)(lnv_b + g * 128 + d8 * 8), bb = *(const f32x4*)(lnv_b + g * 128 + d8 * 8 + 4);
              const float gg[8] = {ga[0], ga[1], ga[2], ga[3], gb[0], gb[1], gb[2], gb[3]};
              const float bbv[8] = {ba[0], ba[1], ba[2], ba[3], bb[0], bb[1], bb[2], bb[3]};
#pragma unroll
              for (int i = 0; i < 4; ++i) { const int s = (tid >> 4) + 32 * i; const u32x4 p = pv[i];
                const float mu = stats[s * 2], rs = stats[s * 2 + 1];
                float f[8] = {bf_lo(p.x), bf_hi(p.x), bf_lo(p.y), bf_hi(p.y), bf_lo(p.z), bf_hi(p.z), bf_lo(p.w), bf_hi(p.w)};
#pragma unroll
                for (int j = 0; j < 8; j += 2) { const float y0 = (f[j] - mu) * rs * gg[j] + bbv[j], y1 = (f[j + 1] - mu) * rs * gg[j + 1] + bbv[j + 1];
                    const unsigned w = cvt_pk_bf16(y0, y1);
                    *(bf16_t*)(VnT + (d8 * 8 + j) * VS + d8 * 16 + s * 2) = (bf16_t)(w & 0xffffu);
                    *(bf16_t*)(VnT + (d8 * 8 + j + 1) * VS + d8 * 16 + s * 2) = (bf16_t)(w >> 16); }
              } }
            __syncthreads();
            { const int gn = g < 7 ? g + 1 : g;
#pragma unroll
              for (int i = 0; i < 4; ++i) pvn[i] = *(const u32x4*)(ZUV + (t0 + (tid >> 4) + 32 * i) * 2048 + 1024 + gn * 128 + (tid & 15) * 8); }
            f32x4 acc[8];
#pragma unroll
            for (int db = 0; db < 8; ++db) acc[db] = (f32x4){0.f, 0.f, 0.f, 0.f};
            const int tl = wid * 16 + l15;
            const int nkc = (wid * 16 + 15) / 32 + 1;
            bf16x8 bw[4];
#pragma unroll
            for (int kc = 0; kc < 4; ++kc) bw[kc] = *(const bf16x8*)(WSP + ((size_t)g * 128 + tl) * 128 + (kc < nkc ? kc : 0) * 32 + g4 * 8);
            const float bs = b_sp[g * 128 + tl];
            const bf16_t* up = ZUV + (t0 + tl) * 2048 + g * 128 + g4 * 4;
            u32x2 uw[8];
#pragma unroll
            for (int db = 0; db < 8; ++db) uw[db] = *(const u32x2*)(up + db * 16);
#pragma unroll
            for (int kc = 0; kc < 4; ++kc) {
                if (kc < nkc) {
#pragma unroll
                    for (int db = 0; db < 8; ++db) {
                        const bf16x8 av = *(const bf16x8*)(VnT + (db * 16 + l15) * VS + (db * 2 + (l15 >> 3)) * 16 + (kc * 32 + g4 * 8) * 2);
                        acc[db] = __builtin_amdgcn_mfma_f32_16x16x32_bf16(av, bw[kc], acc[db], 0, 0, 0);
                    }
                }
            }
            bf16_t* ap = AO + (t0 + tl) * 1024 + g * 128 + g4 * 4;
#pragma unroll
            for (int db = 0; db < 8; ++db) {
                const float r0 = bf_lo(uw[db].x) * (acc[db][0] + bs), r1 = bf_hi(uw[db].x) * (acc[db][1] + bs), r2 = bf_lo(uw[db].y) * (acc[db][2] + bs), r3 = bf_hi(uw[db].y) * (acc[db][3] + bs);
                u32x2 ow; ow.x = cvt_pk_bf16(r0, r1); ow.y = cvt_pk_bf16(r2, r3);
                *(u32x2*)(ap + db * 16) = ow;
            }
            __syncthreads();
        }
    }
}

__device__ __forceinline__ void p_attn(const Args& a, unsigned char* lds) {
    const bf16_t* QKV = (const bf16_t*)(a.ws + WS_QKV); bf16_t* O = (bf16_t*)(a.ws + WS_AO) + (size_t)T * 1024;
    const float* sinks = a.in[9];
    const int tid = threadIdx.x, lane = tid & 63, wid = tid >> 6, g4 = lane >> 4, l15 = lane & 15;
    constexpr int KS = 144, VTS = 528;
    unsigned char* Ks = lds;
    unsigned char* Vt = lds + 36864;
    for (int tl = blockIdx.x; tl < 1024; tl += gridDim.x) {
        const int kvh = tl & 1, n = (tl >> 1) & 63, b = tl >> 7;
        const long tq0 = (long)b * SEQ + (long)n * 128;
        const long tk0 = tq0 - 128;
        __syncthreads();
#pragma unroll
        for (int i = 0; i < 4; ++i) { const int idx = tid + 512 * i, j = idx >> 3, c8 = idx & 7;
            u32x4 kw = (u32x4){0u, 0u, 0u, 0u}, vw = (u32x4){0u, 0u, 0u, 0u};
            if (n > 0 || j >= 128) { const bf16_t* rp = QKV + (size_t)(tk0 + j) * 1280;
                kw = *(const u32x4*)(rp + 1024 + kvh * 64 + c8 * 8); vw = *(const u32x4*)(rp + 1152 + kvh * 64 + c8 * 8); }
            *(u32x4*)(Ks + j * KS + c8 * 16) = kw;
            const unsigned vv[4] = {vw.x, vw.y, vw.z, vw.w};
#pragma unroll
            for (int e = 0; e < 4; ++e) { *(bf16_t*)(Vt + (c8 * 8 + 2 * e) * VTS + c8 * 16 + j * 2) = (bf16_t)(vv[e] & 0xffffu); *(bf16_t*)(Vt + (c8 * 8 + 2 * e + 1) * VTS + c8 * 16 + j * 2) = (bf16_t)(vv[e] >> 16); }
        }
        __syncthreads();
        const int hq = kvh * 8 + wid;
        const float sink = sinks[hq];
        bf16x8 nq0, nq1;
        { const bf16_t* qp = QKV + (size_t)(tq0 + l15) * 1280 + hq * 64 + g4 * 8; nq0 = *(const bf16x8*)qp; nq1 = *(const bf16x8*)(qp + 32); }
#pragma unroll 1
        for (int rb = 0; rb < 8; ++rb) {
            const long tq = tq0 + rb * 16 + l15;
            const bf16x8 q0 = nq0, q1 = nq1;
            if (rb < 7) { const bf16_t* qp = QKV + (size_t)(tq + 16) * 1280 + hq * 64 + g4 * 8; nq0 = *(const bf16x8*)qp; nq1 = *(const bf16x8*)(qp + 32); }
            const int kb0 = rb & ~1;
            f32x4 s[10];
#pragma unroll
            for (int kbi = 0; kbi < 10; ++kbi) { const int kb = kb0 + kbi;
                const bf16x8 k0 = *(const bf16x8*)(Ks + (kb * 16 + l15) * KS + g4 * 16), k1 = *(const bf16x8*)(Ks + (kb * 16 + l15) * KS + 64 + g4 * 16);
                f32x4 c = (f32x4){0.f, 0.f, 0.f, 0.f};
                c = __builtin_amdgcn_mfma_f32_16x16x32_bf16(k0, q0, c, 0, 0, 0);
                c = __builtin_amdgcn_mfma_f32_16x16x32_bf16(k1, q1, c, 0, 0, 0);
                s[kbi] = c; }
            const int qi = rb * 16 + l15 + 128;
            float mx = sink;
#pragma unroll
            for (int kbi = 0; kbi < 10; ++kbi)
#pragma unroll
                for (int r = 0; r < 4; ++r) { const int ki = (kb0 + kbi) * 16 + g4 * 4 + r;
                    const bool valid = (ki <= qi) && (ki > qi - 128) && (n > 0 || ki >= 128);
                    const float v = valid ? s[kbi][r] * 0.125f : -1e30f; s[kbi][r] = v; mx = fmaxf(mx, v); }
            mx = fmaxf(mx, __shfl_xor(mx, 16)); mx = fmaxf(mx, __shfl_xor(mx, 32));
            float l = 0.f;
#pragma unroll
            for (int kbi = 0; kbi < 10; ++kbi)
#pragma unroll
                for (int r = 0; r < 4; ++r) { const float p = __expf(s[kbi][r] - mx); s[kbi][r] = p; l += p; }
            l += __shfl_xor(l, 16); l += __shfl_xor(l, 32);
            l += __expf(sink - mx);
            const float inv = 1.0f / l;
            f32x4 o[4];
#pragma unroll
            for (int db = 0; db < 4; ++db) o[db] = (f32x4){0.f, 0.f, 0.f, 0.f};
#pragma unroll
            for (int c = 0; c < 5; ++c) {
                u32x4 pw; pw.x = cvt_pk_bf16(s[2 * c][0], s[2 * c][1]); pw.y = cvt_pk_bf16(s[2 * c][2], s[2 * c][3]);
                pw.z = cvt_pk_bf16(s[2 * c + 1][0], s[2 * c + 1][1]); pw.w = cvt_pk_bf16(s[2 * c + 1][2], s[2 * c + 1][3]);
                const bf16x8 pb = __builtin_bit_cast(bf16x8, pw);
                const int key0 = (kb0 + 2 * c) * 16 + g4 * 4;
#pragma unroll
                for (int db = 0; db < 4; ++db) {
                    const u32x2 va = *(const u32x2*)(Vt + (db * 16 + l15) * VTS + (db * 2 + (l15 >> 3)) * 16 + key0 * 2), vb = *(const u32x2*)(Vt + (db * 16 + l15) * VTS + (db * 2 + (l15 >> 3)) * 16 + (key0 + 16) * 2);
                    u32x4 vw; vw.x = va.x; vw.y = va.y; vw.z = vb.x; vw.w = vb.y;
                    o[db] = __builtin_amdgcn_mfma_f32_16x16x32_bf16(__builtin_bit_cast(bf16x8, vw), pb, o[db], 0, 0, 0);
                }
            }
            bf16_t* op = O + (size_t)tq * 1024 + hq * 64 + g4 * 4;
#pragma unroll
            for (int db = 0; db < 4; ++db) { u32x2 ow; ow.x = cvt_pk_bf16(o[db][0] * inv, o[db][1] * inv); ow.y = cvt_pk_bf16(o[db][2] * inv, o[db][3] * inv);
                *(u32x2*)(op + db * 16) = ow; }
        }
    }
}

__device__ __forceinline__ void p_ln1(const Args& a) {
    const bf16_t* Y1 = (const bf16_t*)(a.ws + WS_ZUV); const float* mod = (const float*)(a.ws + WS_MOD);
    float* stats = (float*)(a.ws + WS_STATS); bf16_t* H2 = (bf16_t*)(a.ws + WS_QKV);
    const float* g1 = a.in[13]; const float* b1 = a.in[14];
    const int lane = threadIdx.x & 63; const int gw = blockIdx.x * 8 + (threadIdx.x >> 6), nw = gridDim.x * 8;
    float gg[16], bb[16];
#pragma unroll
    for (int h = 0; h < 2; ++h)
#pragma unroll
        for (int j = 0; j < 8; ++j) { gg[h * 8 + j] = g1[h * 512 + lane * 8 + j]; bb[h * 8 + j] = b1[h * 512 + lane * 8 + j]; }
    int t = gw; if (t >= T) return;
    u32x4 n0 = *(const u32x4*)(Y1 + (size_t)t * 1024 + lane * 8), n1 = *(const u32x4*)(Y1 + (size_t)t * 1024 + 512 + lane * 8);
    for (; t < T; t += nw) {
        const u32x4 p0 = n0, p1 = n1;
        const int tn = t + nw < T ? t + nw : t;
        n0 = *(const u32x4*)(Y1 + (size_t)tn * 1024 + lane * 8); n1 = *(const u32x4*)(Y1 + (size_t)tn * 1024 + 512 + lane * 8);
        const int b = t >> 13; const float* mp = mod + b * 6144;
        float v[16] = {bf_lo(p0.x), bf_hi(p0.x), bf_lo(p0.y), bf_hi(p0.y), bf_lo(p0.z), bf_hi(p0.z), bf_lo(p0.w), bf_hi(p0.w),
                       bf_lo(p1.x), bf_hi(p1.x), bf_lo(p1.y), bf_hi(p1.y), bf_lo(p1.z), bf_hi(p1.z), bf_lo(p1.w), bf_hi(p1.w)};
        float sm = 0.f;
#pragma unroll
        for (int j = 0; j < 16; ++j) sm += v[j];
        const float mu = wave_sum(sm) * (1.0f / 1024.0f);
        float q = 0.f;
#pragma unroll
        for (int j = 0; j < 16; ++j) { const float d = v[j] - mu; q += d * d; }
        const float rs = rsqrtf(wave_sum(q) * (1.0f / 1024.0f) + LN_EPS);
        if (lane == 0) { stats[t * 2] = mu; stats[t * 2 + 1] = rs; }
#pragma unroll
        for (int h = 0; h < 2; ++h) { const int col = h * 512 + lane * 8; float r[8];
            const f32x4 sc0 = *(const f32x4*)(mp + 4096 + col), sc1 = *(const f32x4*)(mp + 4096 + col + 4), sh0 = *(const f32x4*)(mp + 3072 + col), sh1 = *(const f32x4*)(mp + 3072 + col + 4);
#pragma unroll
            for (int j = 0; j < 8; ++j) { const float x1v = (v[h * 8 + j] - mu) * rs * gg[h * 8 + j] + bb[h * 8 + j]; r[j] = x1v * (1.0f + (j < 4 ? sc0[j] : sc1[j - 4])) + (j < 4 ? sh0[j] : sh1[j - 4]); }
            u32x4 w; w.x = cvt_pk_bf16(r[0], r[1]); w.y = cvt_pk_bf16(r[2], r[3]); w.z = cvt_pk_bf16(r[4], r[5]); w.w = cvt_pk_bf16(r[6], r[7]);
            *(u32x4*)(H2 + (size_t)t * 1024 + col) = w; }
    }
}

__device__ __forceinline__ unsigned ordf(float f) { const unsigned b = __float_as_uint(f); return b ^ ((unsigned)((int)b >> 31) | 0x80000000u); }
__device__ __forceinline__ float unordf(unsigned u) { const unsigned b = (u & 0x80000000u) ? (u ^ 0x80000000u) : ~u; return __uint_as_float(b); }
__device__ __forceinline__ void bitonic_sort16(unsigned (&k)[16]) {
#pragma unroll
    for (int size = 2; size <= 16; size <<= 1) {
#pragma unroll
        for (int stride = size >> 1; stride >= 1; stride >>= 1) {
#pragma unroll
            for (int i = 0; i < 16; ++i) { const int l = i ^ stride;
                if (l > i) { const bool desc = ((i & size) == 0); const unsigned hi = max(k[i], k[l]), lo = min(k[i], k[l]); k[i] = desc ? hi : lo; k[l] = desc ? lo : hi; } }
        }
    }
}
__device__ __forceinline__ void bitonic_merge16(unsigned (&k)[16]) {
#pragma unroll
    for (int stride = 8; stride >= 1; stride >>= 1) {
#pragma unroll
        for (int i = 0; i < 16; ++i) { const int l = i ^ stride;
            if (l > i) { const unsigned hi = max(k[i], k[l]), lo = min(k[i], k[l]); k[i] = hi; k[l] = lo; } }
    }
}
__device__ __forceinline__ void merge_across4(unsigned (&c)[16]) {
#pragma unroll
    for (int lv = 16; lv <= 32; lv <<= 1) {
        unsigned p[16];
#pragma unroll
        for (int i = 0; i < 16; ++i) p[i] = (unsigned)__shfl_xor((int)c[15 - i], lv);
#pragma unroll
        for (int i = 0; i < 16; ++i) c[i] = max(c[i], p[i]);
        bitonic_merge16(c);
    }
}
__device__ __forceinline__ void peer_half_scores(const unsigned char* SKl  , const bf16x8 (&qf)[4], int l15, int g4, unsigned (&sel)[16]) {
    unsigned ka[16], kb2[16];
#pragma unroll
    for (int kb = 0; kb < 8; ++kb) { f32x4 c = (f32x4){0.f, 0.f, 0.f, 0.f};
#pragma unroll
        for (int ks = 0; ks < 4; ++ks) { const bf16x8 kf = *(const bf16x8*)(SKl + (kb * 16 + l15) * 272 + ks * 64 + g4 * 16);
            c = __builtin_amdgcn_mfma_f32_16x16x32_bf16(kf, qf[ks], c, 0, 0, 0); }
#pragma unroll
        for (int r = 0; r < 4; ++r) { const unsigned kk = (ordf(c[r]) & ~127u) | (unsigned)(kb * 16 + g4 * 4 + r);
            if (kb < 4) ka[kb * 4 + r] = kk; else kb2[(kb - 4) * 4 + r] = kk; }
        if (kb & 1) __builtin_amdgcn_sched_barrier(0); }
    bitonic_sort16(ka); bitonic_sort16(kb2);
#pragma unroll
    for (int i = 0; i < 16; ++i) sel[i] = max(ka[i], kb2[15 - i]);
    bitonic_merge16(sel);
    merge_across4(sel);
}
__host__ __device__ constexpr int cand_i(int g, int s) { return g == 0 ? 0 : g == 1 ? (s < 8 ? 1 : s < 13 ? 2 : 3) : g == 2 ? (s == 0 ? 3 : s < 4 ? 4 : s < 6 ? 5 : s < 8 ? 6 : s < 10 ? 7 : s - 2) : (s == 0 ? 14 : 15); }
__host__ __device__ constexpr int cand_j(int g, int s) { return g == 0 ? s : g == 1 ? (s < 8 ? s : s < 13 ? s - 8 : s - 13) : g == 2 ? (s == 0 ? 3 : s < 4 ? s - 1 : s < 6 ? s - 4 : s < 8 ? s - 6 : s < 10 ? s - 8 : 0) : 0; }

__device__ __forceinline__ void p_topk(const Args& a, unsigned char* lds) {
    const bf16_t* Q = (const bf16_t*)(a.ws + WS_GATES); const bf16_t* SK = (const bf16_t*)(a.ws + WS_SK);
    int* IDX = (int*)(a.ws + WS_IDX); float* WGT = (float*)(a.ws + WS_WGT);
    const int tid = threadIdx.x, lane = tid & 63, wid = tid >> 6, g4 = lane >> 4, l15 = lane & 15;
    for (int unit = blockIdx.x; unit < 256; unit += gridDim.x) {
        const int h = unit & 7, c = unit >> 3;
        __syncthreads();
#pragma unroll
        for (int i = 0; i < 8; ++i) { const int idx = tid + 512 * i, half = idx >> 11, row = (idx >> 4) & 127, pc = idx & 15;
            const u32x4 v = *(const u32x4*)(SK + (size_t)half * 131072 + (size_t)h * 16384 + row * 128 + pc * 8);
            *(u32x4*)(lds + half * 34816 + row * 272 + pc * 16) = v; }
        __syncthreads();
      bf16x8 nq[8];
      { const size_t t0q = (size_t)(c * 128 + wid) * 16 + l15; const bf16_t* qp = Q + t0q * 2048 + h * 256 + g4 * 8;
#pragma unroll
        for (int ks = 0; ks < 4; ++ks) { nq[ks] = *(const bf16x8*)(qp + ks * 32); nq[4 + ks] = *(const bf16x8*)(qp + 128 + ks * 32); } }
#pragma unroll 1
      for (int it = 0; it < 16; ++it) {
        const int tb = c * 128 + it * 8 + wid;
        const size_t t = (size_t)tb * 16 + l15;
        bf16x8 q1[4], q2[4];
#pragma unroll
        for (int ks = 0; ks < 4; ++ks) { q1[ks] = nq[ks]; q2[ks] = nq[4 + ks]; }
        { const int tbn = it < 15 ? tb + 8 : tb; const bf16_t* qp = Q + ((size_t)tbn * 16 + l15) * 2048 + h * 256 + g4 * 8;
#pragma unroll
          for (int ks = 0; ks < 4; ++ks) { nq[ks] = *(const bf16x8*)(qp + ks * 32); nq[4 + ks] = *(const bf16x8*)(qp + 128 + ks * 32); } }
        unsigned sel1[16], sel2[16];
        peer_half_scores(lds, q1, l15, g4, sel1);
        peer_half_scores(lds + 34816, q2, l15, g4, sel2);
        unsigned ck[16];
#pragma unroll
        for (int s = 0; s < 16; ++s) {
            const unsigned s1 = g4 == 0 ? sel1[cand_i(0, s)] : g4 == 1 ? sel1[cand_i(1, s)] : g4 == 2 ? sel1[cand_i(2, s)] : sel1[cand_i(3, s)];
            const unsigned s2 = g4 == 0 ? sel2[cand_j(0, s)] : g4 == 1 ? sel2[cand_j(1, s)] : g4 == 2 ? sel2[cand_j(2, s)] : sel2[cand_j(3, s)];
            const float sm = unordf(s1 & ~127u) + unordf(s2 & ~127u);
            const unsigned kk = (ordf(sm) & 0xFFFFC000u) | ((s1 & 127u) << 7) | (s2 & 127u);
            ck[s] = (g4 < 3 || s < 2) ? kk : 0u;
        }
        bitonic_sort16(ck);
        merge_across4(ck);
        float wsc[16];
        const float mx0 = unordf(ck[0] & 0xFFFFC000u); float sum = 0.f;
#pragma unroll
        for (int rd = 0; rd < 16; ++rd) { wsc[rd] = __expf(unordf(ck[rd] & 0xFFFFC000u) - mx0); sum += wsc[rd]; }
        const float inv = 1.0f / sum;
        if (g4 == 0) {
            int* ip = IDX + t * 128 + h * 16; float* wp = WGT + t * 128 + h * 16;
#pragma unroll
            for (int q4 = 0; q4 < 4; ++q4) {
                *(u32x4*)(ip + q4 * 4) = (u32x4){ck[q4 * 4] & 0x3FFFu, ck[q4 * 4 + 1] & 0x3FFFu, ck[q4 * 4 + 2] & 0x3FFFu, ck[q4 * 4 + 3] & 0x3FFFu};
                *(f32x4*)(wp + q4 * 4) = (f32x4){wsc[q4 * 4] * inv, wsc[q4 * 4 + 1] * inv, wsc[q4 * 4 + 2] * inv, wsc[q4 * 4 + 3] * inv};
            }
        }
      }
    }
}

template <int CTRL> __device__ __forceinline__ float dpp_f(float v) { return __builtin_bit_cast(float, __builtin_amdgcn_update_dpp(0, __builtin_bit_cast(int, v), CTRL, 0xF, 0xF, true)); }
__device__ __forceinline__ f32x32 fp6x32(const u32x4 a, const u32x2 b) { const u32x6 v = {a.x, a.y, a.z, a.w, b.x, b.y}; return __builtin_amdgcn_cvt_scalef32_pk32_f32_fp6(v, 1.0f); }
__device__ __forceinline__ void p_gdot(const Args& a) {
    const unsigned char* ws = a.ws;
    const bf16_t* H2 = (const bf16_t*)(ws + WS_QKV); const int* IDX = (const int*)(ws + WS_IDX); float* WGT = (float*)(ws + WS_WGT);
    const unsigned char* PU = ws + WS_PU;
    const int lane = threadIdx.x & 63, l31 = lane & 31; const int gw = blockIdx.x * 8 + (threadIdx.x >> 6), nw = gridDim.x * 8;
    const bool up32 = (lane & 32) != 0, up16 = (lane & 16) != 0, up8 = (lane & 8) != 0;
    const int ebi = 2 * (2 * (up16 ? 1 : 0) + (up8 ? 1 : 0)) + (up32 ? 1 : 0);
    int t = gw;
    int ev0 = 0, ev1 = 0; float wv0 = 0.f, wv1 = 0.f;
    if (t < T) { ev0 = IDX[(size_t)t * 128 + lane]; ev1 = IDX[(size_t)t * 128 + 64 + lane]; wv0 = WGT[(size_t)t * 128 + lane]; wv1 = WGT[(size_t)t * 128 + 64 + lane]; }
#define U_LOADX(U4, U2, E0, E1, kbase) do { const int _evs = (kbase) < 64 ? E0 : E1; _Pragma("unroll") for (int s = 0; s < 4; ++s) { \
        const int e0 = __builtin_amdgcn_readlane(_evs, ((kbase) & 63) + 2 * s), e1 = __builtin_amdgcn_readlane(_evs, ((kbase) & 63) + 2 * s + 1); const int e = up32 ? e1 : e0; \
        const unsigned char* up = PU + (size_t)e * 768 + l31 * 24; U4[s] = *(const u32x4_a8*)up; U2[s] = *(const u32x2*)(up + 16); } } while (0)
#define U_COMP(U4, U2, kbase) do { float d[4]; \
        _Pragma("unroll") for (int s = 0; s < 4; ++s) { const f32x32 uf = fp6x32(U4[s], U2[s]); f32x2 sacc = (f32x2){uf[0], uf[1]} * hf[0]; \
            _Pragma("unroll") for (int i = 1; i < 16; ++i) sacc += (f32x2){uf[2 * i], uf[2 * i + 1]} * hf[i]; d[s] = sacc.x + sacc.y; } \
        float k2[2]; _Pragma("unroll") for (int j = 0; j < 2; ++j) { const float snd = up16 ? d[j] : d[j + 2], keep = up16 ? d[j + 2] : d[j]; k2[j] = keep + __shfl_xor(snd, 16); } \
        float r = (up8 ? k2[1] : k2[0]) + dpp_f<0x140>(up8 ? k2[0] : k2[1]); \
        r += dpp_f<0x141>(r); r += dpp_f<0x4E>(r); r += dpp_f<0xB1>(r); \
        const float wsel = __shfl((kbase) < 64 ? wv0 : wv1, ((kbase) & 63) + ebi); \
        const float x = r * (1.0f / PU_SCALE); const float cv = 0.5f * x * (1.0f + erff(x * 0.70710678118f)) * wsel * (1.0f / PV_SCALE); \
        if ((lane & 7) == 0) cp[(kbase) + ebi] = cv; } while (0)
    u32x4 UA4[4], UB4[4]; u32x2 UA2[4], UB2[4]; u32x4 hr[4];
#pragma unroll
    for (int q = 0; q < 4; ++q) hr[q] = (u32x4){0u, 0u, 0u, 0u};
    if (t < T) { U_LOADX(UA4, UA2, ev0, ev1, 0);
#pragma unroll
        for (int q = 0; q < 4; ++q) hr[q] = *(const u32x4*)(H2 + (size_t)t * 1024 + l31 * 32 + q * 8); }
    for (; t < T; t += nw) {
        f32x2 hf[16];
#pragma unroll
        for (int q = 0; q < 4; ++q) { hf[q * 4 + 0] = (f32x2){bf_lo(hr[q].x), bf_hi(hr[q].x)}; hf[q * 4 + 1] = (f32x2){bf_lo(hr[q].y), bf_hi(hr[q].y)};
            hf[q * 4 + 2] = (f32x2){bf_lo(hr[q].z), bf_hi(hr[q].z)}; hf[q * 4 + 3] = (f32x2){bf_lo(hr[q].w), bf_hi(hr[q].w)}; }
        const int tn = t + nw < T ? t + nw : t;
        const int nev0 = IDX[(size_t)tn * 128 + lane], nev1 = IDX[(size_t)tn * 128 + 64 + lane]; const float nwv0 = WGT[(size_t)tn * 128 + lane], nwv1 = WGT[(size_t)tn * 128 + 64 + lane];
#pragma unroll
        for (int q = 0; q < 4; ++q) hr[q] = *(const u32x4*)(H2 + (size_t)tn * 1024 + l31 * 32 + q * 8);
        float* cp = WGT + (size_t)t * 128;
#pragma unroll 1
        for (int b2 = 0; b2 < 8; ++b2) {
            U_LOADX(UB4, UB2, ev0, ev1, 16 * b2 + 8);
            U_COMP(UA4, UA2, 16 * b2);
            if (b2 < 7) U_LOADX(UA4, UA2, ev0, ev1, 16 * b2 + 16); else U_LOADX(UA4, UA2, nev0, nev1, 0);
            U_COMP(UB4, UB2, 16 * b2 + 8);
        }
        ev0 = nev0; ev1 = nev1; wv0 = nwv0; wv1 = nwv1;
    }
#undef U_LOADX
#undef U_COMP
}

__device__ __forceinline__ void p_gather(const Args& a) {
    const unsigned char* ws = a.ws;
    const bf16_t* Y1 = (const bf16_t*)(ws + WS_ZUV); const float* stats = (const float*)(ws + WS_STATS); const float* mod = (const float*)(ws + WS_MOD);
    const int* IDX = (const int*)(ws + WS_IDX); const float* WGT = (const float*)(ws + WS_WGT);
    const unsigned char* PV = ws + WS_PV;
    const float* g1 = a.in[13]; const float* b1 = a.in[14]; const float* g2 = a.in[20]; const float* b2 = a.in[21];
    const int lane = threadIdx.x & 63, l31 = lane & 31; const int gw = blockIdx.x * 8 + (threadIdx.x >> 6), nw = gridDim.x * 8;
    const bool up32 = (lane & 32) != 0;
    int t = gw;
    int ev0 = 0, ev1 = 0; float wv0 = 0.f, wv1 = 0.f;
    if (t < T) { ev0 = IDX[(size_t)t * 128 + lane]; ev1 = IDX[(size_t)t * 128 + 64 + lane]; wv0 = WGT[(size_t)t * 128 + lane]; wv1 = WGT[(size_t)t * 128 + 64 + lane]; }
#define V_LOADX(V4, V2, E0, E1, kbase) do { const int _evs = (kbase) < 64 ? E0 : E1; _Pragma("unroll") for (int s = 0; s < 4; ++s) { \
        const int e0 = __builtin_amdgcn_readlane(_evs, ((kbase) & 63) + 2 * s), e1 = __builtin_amdgcn_readlane(_evs, ((kbase) & 63) + 2 * s + 1); const int e = up32 ? e1 : e0; \
        const unsigned char* vp = PV + (size_t)e * 768 + l31 * 24; V4[s] = *(const u32x4_a8*)vp; V2[s] = *(const u32x2*)(vp + 16); } } while (0)
#define V_COMP(V4, V2, kbase) do { const int _wvs = __builtin_bit_cast(int, (kbase) < 64 ? wv0 : wv1); _Pragma("unroll") for (int s = 0; s < 4; ++s) { \
        const float c0 = __builtin_bit_cast(float, __builtin_amdgcn_readlane(_wvs, ((kbase) & 63) + 2 * s)), c1 = __builtin_bit_cast(float, __builtin_amdgcn_readlane(_wvs, ((kbase) & 63) + 2 * s + 1)); \
        const float cj = up32 ? c1 : c0; const f32x2 cc = (f32x2){cj, cj}; const f32x32 vf = fp6x32(V4[s], V2[s]); \
        _Pragma("unroll") for (int i = 0; i < 16; ++i) acc[i] += cc * (f32x2){vf[2 * i], vf[2 * i + 1]}; } } while (0)
    u32x4 VA4[4], VB4[4]; u32x2 VA2[4], VB2[4];
    if (t < T) V_LOADX(VA4, VA2, ev0, ev1, 0);
    for (; t < T; t += nw) {
        f32x2 acc[16];
#pragma unroll
        for (int j = 0; j < 16; ++j) acc[j] = (f32x2){0.f, 0.f};
        const int tn = t + nw < T ? t + nw : t;
        const int nev0 = IDX[(size_t)tn * 128 + lane], nev1 = IDX[(size_t)tn * 128 + 64 + lane]; const float nwv0 = WGT[(size_t)tn * 128 + lane], nwv1 = WGT[(size_t)tn * 128 + 64 + lane];
        const int colp = l31 * 32 + (up32 ? 16 : 0);
        u32x2 ywp[4];
#pragma unroll
        for (int q4 = 0; q4 < 4; ++q4) ywp[q4] = *(const u32x2*)(Y1 + (size_t)t * 1024 + colp + q4 * 4);
        const float mu1 = stats[t * 2], rs1 = stats[t * 2 + 1];
#pragma unroll 1
        for (int b2 = 0; b2 < 8; ++b2) {
            V_LOADX(VB4, VB2, ev0, ev1, 16 * b2 + 8);
            V_COMP(VA4, VA2, 16 * b2);
            if (b2 < 7) V_LOADX(VA4, VA2, ev0, ev1, 16 * b2 + 16); else V_LOADX(VA4, VA2, nev0, nev1, 0);
            V_COMP(VB4, VB2, 16 * b2 + 8);
        }
        float f[16];
#pragma unroll
        for (int j = 0; j < 8; ++j) {
            const float s0 = up32 ? acc[j].x : acc[8 + j].x, s1 = up32 ? acc[j].y : acc[8 + j].y;
            const float r0 = __shfl_xor(s0, 32), r1 = __shfl_xor(s1, 32);
            f[2 * j] = (up32 ? acc[8 + j].x : acc[j].x) + r0; f[2 * j + 1] = (up32 ? acc[8 + j].y : acc[j].y) + r1; }
        const int b = t >> 13; const float* mp = mod + b * 6144 + 5120;
        const int col = colp;
        float y[16];
#pragma unroll
        for (int q4 = 0; q4 < 4; ++q4) { const u32x2 yw = ywp[q4]; const f32x4 yv = (f32x4){bf_lo(yw.x), bf_hi(yw.x), bf_lo(yw.y), bf_hi(yw.y)};
            const f32x4 gg = *(const f32x4*)(g1 + col + q4 * 4), bb = *(const f32x4*)(b1 + col + q4 * 4), gt = *(const f32x4*)(mp + col + q4 * 4);
#pragma unroll
            for (int j = 0; j < 4; ++j) { const float x1v = (yv[j] - mu1) * rs1 * gg[j] + bb[j]; y[q4 * 4 + j] = ALPHA * x1v + (1.0f + gt[j]) * f[q4 * 4 + j]; } }
        float sm = 0.f;
#pragma unroll
        for (int j = 0; j < 16; ++j) sm += y[j];
        const float mu = wave_sum(sm) * (1.0f / 1024.0f);
        float q = 0.f;
#pragma unroll
        for (int j = 0; j < 16; ++j) { const float dd = y[j] - mu; q += dd * dd; }
        const float rs = rsqrtf(wave_sum(q) * (1.0f / 1024.0f) + LN_EPS);
#pragma unroll
        for (int q4 = 0; q4 < 4; ++q4) { const f32x4 gg = *(const f32x4*)(g2 + col + q4 * 4), bb = *(const f32x4*)(b2 + col + q4 * 4); f32x4 o;
#pragma unroll
            for (int j = 0; j < 4; ++j) o[j] = (y[q4 * 4 + j] - mu) * rs * gg[j] + bb[j];
            *(f32x4*)(a.out + (size_t)t * 1024 + col + q4 * 4) = o; }
        ev0 = nev0; ev1 = nev1; wv0 = nwv0; wv1 = nwv1;
    }
#undef V_LOADX
#undef V_COMP
}

#define XB_TMO      128
#define XB_XCNT(j)  (256  + 64 * (j))
#define XB_XSUB(j)  (1280 + 64 * (j))
#define XB_XGEN(j)  (2304 + 64 * (j))
#define XB_TOP      3328
#define XB_TOPGEN   3392
#define XCD_BAR_WORDS 3456
#define XB_SPIN_CAP (1u << 18)
__device__ __forceinline__ unsigned xb_ld(unsigned* p)              { return __hip_atomic_load(p, __ATOMIC_RELAXED, __HIP_MEMORY_SCOPE_AGENT); }
__device__ __forceinline__ unsigned xb_add(unsigned* p, unsigned v) { return __hip_atomic_fetch_add(p, v, __ATOMIC_RELAXED, __HIP_MEMORY_SCOPE_AGENT); }
__device__ __forceinline__ unsigned xb_xcc_id() { return (unsigned)__builtin_amdgcn_s_getreg((3 << 11) | 20) & 0xFu; }
#define XB_SPIN(cond, bar) do { unsigned _sp = 0; while (cond) { __builtin_amdgcn_s_sleep(1); \
    if ((++_sp & 255u) == 0u) { if (xb_ld(&(bar)[XB_TMO])) break; if (_sp > XB_SPIN_CAP) { atomicAdd(&(bar)[XB_TMO], 1u); break; } } } } while (0)
struct XcdBarrier { unsigned* bar; unsigned x; volatile LAS unsigned* st; };
__device__ __forceinline__ XcdBarrier xcd_barrier_post(unsigned* bar, volatile LAS unsigned* st) {
    XcdBarrier b; b.bar = bar; b.x = xb_xcc_id(); b.st = st;
    if (threadIdx.x == 0) (void)xb_add(&bar[XB_XCNT(b.x)], 1u);
    return b;
}
__device__ __forceinline__ void xcd_barrier_complete(unsigned* bar, unsigned x, unsigned& nloc, unsigned& nx) {
    const unsigned G = gridDim.x * gridDim.y * gridDim.z;
    unsigned sum, cnt, mine, sp = 0u;
    for (;;) {
        sum = 0u; cnt = 0u; mine = 0u;
#pragma unroll
        for (unsigned j = 0; j < 16; ++j) { const unsigned c = xb_ld(&bar[XB_XCNT(j)]); sum += c; cnt += (c > 0u) ? 1u : 0u; mine = (j == x) ? c : mine; }
        if (sum == G) break;
        __builtin_amdgcn_s_sleep(1);
        if ((++sp & 255u) == 0u) { if (xb_ld(&bar[XB_TMO])) break; if (sp > XB_SPIN_CAP) { atomicAdd(&bar[XB_TMO], 1u); break; } }
    }
    nloc = mine > 0u ? mine : 1u; nx = cnt > 0u ? cnt : 1u;
}
__device__ __forceinline__ void xcd_barrier(const XcdBarrier& b) {
    asm volatile("s_waitcnt vmcnt(0)" ::: "memory");
    __syncthreads();
    if (threadIdx.x == 0) {
        unsigned* bar = b.bar;
        __builtin_amdgcn_s_waitcnt(0);
        unsigned nloc = b.st[0], nx = b.st[1];
        if (nloc == 0u) { xcd_barrier_complete(bar, b.x, nloc, nx); b.st[0] = nloc; b.st[1] = nx; }
        const unsigned old = xb_add(&bar[XB_XSUB(b.x)], 1u);
        const unsigned gen = old / nloc;
        if (old + 1u == (gen + 1u) * nloc) {
            __builtin_amdgcn_fence(__ATOMIC_RELEASE, "agent");
            asm volatile("s_waitcnt vmcnt(0)" ::: "memory");
            const unsigned og = xb_add(&bar[XB_TOP], 1u);
            const unsigned tg = og / nx;
            if (og + 1u == (tg + 1u) * nx) xb_add(&bar[XB_TOPGEN], 1u);
            else XB_SPIN(xb_ld(&bar[XB_TOPGEN]) == tg, bar);
            __builtin_amdgcn_fence(__ATOMIC_ACQUIRE, "agent");
            xb_add(&bar[XB_XGEN(b.x)], 1u);
            asm volatile("s_waitcnt vmcnt(0)" ::: "memory");
        } else {
            XB_SPIN(xb_ld(&bar[XB_XGEN(b.x)]) == gen, bar);
            __builtin_amdgcn_fence(__ATOMIC_ACQUIRE, "agent");
            asm volatile("s_waitcnt vmcnt(0)" ::: "memory");
        }
    }
    __syncthreads();
}

constexpr int NPHASE = 11;
constexpr int LDS_BYTES = 128 * 1024 + 1024;

#ifndef REPEAT_MASK
#define REPEAT_MASK 0
#endif
__global__ void __launch_bounds__(512) mega(Args a) {
    extern __shared__ __attribute__((aligned(16))) unsigned char lds[];
    cg::grid_group grid = cg::this_grid();
    const int lo = a.ph_lo, hi = a.ph_hi;
    unsigned char* ws = a.ws;
    const int G = gridDim.x;
    XcdBarrier xbar; xbar.bar = (unsigned*)(ws + WS_BAR); xbar.x = 0; xbar.st = (volatile LAS unsigned*)((LAS unsigned char*)lds + 131072);
    if (hi - lo > 1) {
        if (threadIdx.x < 4) ((LAS unsigned*)((LAS unsigned char*)lds + 131072))[threadIdx.x] = 0u;
        __syncthreads();
        xbar = xcd_barrier_post((unsigned*)(ws + WS_BAR), (volatile LAS unsigned*)((LAS unsigned char*)lds + 131072));
    }
#define IN(k) (lo <= (k) && (k) < hi)
#define PH(k, ...) do { if (IN(k)) { __VA_ARGS__; if ((REPEAT_MASK >> (k)) & 1) { grid.sync(); __VA_ARGS__; } } if (IN(k) && IN((k) + 1)) { if ((k) == 0) grid.sync(); else xcd_barrier(xbar); } } while (0)
    PH(0, p_prep(a, lds));
    PH(1, p_h(a));
    PH(2, {
        pg8::Gemm g{(const bf16_t*)(ws + WS_AO), (const bf16_t*)(ws + WS_WIN), T, 5376, 1024}; pg8::StaticOrder S; S.init(T, 5376, G, (int)blockIdx.x);
        EpiProj E{(bf16_t*)(ws + WS_ZUV), (bf16_t*)(ws + WS_QKV), (bf16_t*)(ws + WS_GATES)};
        pg8::gemm_phase((LAS unsigned char*)lds, g, S, E); });
    PH(3, { p_gmlp(a, lds); __syncthreads(); p_attn(a, lds); });
    PH(4, {
        pg8::Gemm g{(const bf16_t*)(ws + WS_AO), (const bf16_t*)(ws + WS_WAB), 2 * T, 2048, 1024}; pg8::PairOrder S; S.so.init(T, 1024, G, (int)blockIdx.x);
        EpiMerge E{(const bf16_t*)(ws + WS_GATES), (bf16_t*)(ws + WS_QKV)};
        pg8::gemm_phase((LAS unsigned char*)lds, g, S, E); });
    PH(5, {
        pg8::Gemm g{(const bf16_t*)(ws + WS_QKV), (const bf16_t*)(ws + WS_WOUT), T, 1024, 1024}; pg8::StaticOrder S; S.init(T, 1024, G, (int)blockIdx.x);
        EpiY1 E{a.in[0], (const float*)(ws + WS_MOD), (bf16_t*)(ws + WS_ZUV)};
        pg8::gemm_phase((LAS unsigned char*)lds, g, S, E); });
    PH(6, p_ln1(a));
    PH(7, {
        pg8::Gemm g{(const bf16_t*)(ws + WS_QKV), (const bf16_t*)(ws + WS_WPQ), T, 2048, 1024}; pg8::StaticOrder S; S.init(T, 2048, G, (int)blockIdx.x);
        EpiQ E{(bf16_t*)(ws + WS_GATES)};
        pg8::gemm_phase((LAS unsigned char*)lds, g, S, E); });
    PH(8, p_topk(a, lds));
    PH(9, p_gdot(a));
    PH(10, p_gather(a));
#undef IN
#undef PH
}

extern "C" void kernel_launch(void* const* d_in, const int* in_sizes, int n_in, void* d_out, int out_size, void* d_ws, size_t ws_size, hipStream_t stream) {
    static int grid = 0;
    if (grid == 0) {
        if (n_in != 22 || ws_size < WS_END) { fprintf(stderr, "kernel_launch: unexpected n_in %d or ws_size %zu (< %zu)\n", n_in, ws_size, (size_t)WS_END); grid = -1; return; }
        int dev = 0, cus = 0, per_cu = 0;
        (void)hipGetDevice(&dev); (void)hipDeviceGetAttribute(&cus, hipDeviceAttributeMultiprocessorCount, dev);
        if (hipFuncSetAttribute((const void*)mega, hipFuncAttributeMaxDynamicSharedMemorySize, LDS_BYTES) != hipSuccess) { fprintf(stderr, "kernel_launch: hipFuncSetAttribute failed\n"); grid = -1; return; }
        if (hipOccupancyMaxActiveBlocksPerMultiprocessor(&per_cu, (const void*)mega, 512, LDS_BYTES) != hipSuccess || per_cu < 1) { fprintf(stderr, "kernel_launch: occupancy query says %d\n", per_cu); per_cu = 1; }
        (void)hipGetLastError();
        grid = cus > 0 ? cus : 256;
    }
    if (grid < 0) return;
    Args a{};
    for (int i = 0; i < 22; ++i) a.in[i] = (const float*)d_in[i];
    a.out = (float*)d_out; a.ws = (unsigned char*)d_ws;
#if ONE_LAUNCH
    if (hipMemsetAsync((char*)d_ws + WS_BAR, 0, XCD_BAR_WORDS * sizeof(unsigned), stream) != hipSuccess) { fprintf(stderr, "kernel_launch: memset of the barrier words failed\n"); return; }
    a.ph_lo = 0; a.ph_hi = NPHASE;
    void* args[] = {&a};
    hipError_t e = hipLaunchCooperativeKernel((const void*)mega, dim3(grid), dim3(512), args, LDS_BYTES, stream);
    if (e != hipSuccess) fprintf(stderr, "cooperative launch failed: %s (grid %d)\n", hipGetErrorString(e), grid);
#else
    for (int p = 0; p < NPHASE; ++p) { a.ph_lo = p; a.ph_hi = p + 1; hipLaunchKernelGGL(mega, dim3(grid), dim3(512), LDS_BYTES, stream, a); }
#endif
}
```

```cpp
#include <hip/hip_runtime.h>
#include <hip/hip_cooperative_groups.h>
#include <cstdio>
namespace cg = cooperative_groups;

#ifndef ONE_LAUNCH
#define ONE_LAUNCH 1
#endif

#define LAS __attribute__((address_space(3)))
typedef unsigned short bf16_t;
typedef short bf16x8 __attribute__((ext_vector_type(8)));
typedef float f32x4 __attribute__((ext_vector_type(4)));
typedef float f32x2 __attribute__((ext_vector_type(2)));
typedef unsigned u32x4 __attribute__((ext_vector_type(4)));
typedef unsigned u32x2 __attribute__((ext_vector_type(2)));

constexpr int T = 65536, D = 1024, SEQ = 8192;
constexpr size_t MiB = 1ull << 20;
constexpr size_t WS_ZUV = 0;
constexpr size_t WS_QKV = 256 * MiB;
constexpr size_t WS_GATES = 416 * MiB;
constexpr size_t WS_AO = 672 * MiB;
constexpr size_t WS_IDX = WS_AO;
constexpr size_t WS_WGT = WS_AO + 32 * MiB;
constexpr size_t WS_WIN = 928 * MiB;
constexpr size_t WS_WAB = WS_WIN + (size_t)5376 * 1024 * 2;
constexpr size_t WS_WOUT = WS_WAB + 4 * MiB;
constexpr size_t WS_WPQ = WS_WOUT + 2 * MiB;
constexpr size_t WS_SK = WS_WPQ + 4 * MiB;
constexpr size_t WS_WSP = WS_SK + 512 * 1024;
constexpr size_t WS_PU = WS_WSP + 256 * 1024;
constexpr size_t WS_PV = WS_PU + 32 * MiB;
constexpr size_t WS_MOD = WS_PV + 32 * MiB;
constexpr size_t WS_STATS = WS_MOD + 256 * 1024;
constexpr size_t WS_BAR = WS_STATS + 512 * 1024;
constexpr size_t WS_END = WS_BAR + 16 * 1024;

constexpr float ALPHA = 1.18920711500272f;
constexpr float LN_EPS = 1e-5f;

__device__ __forceinline__ unsigned cvt_pk_bf16(float lo, float hi) { unsigned r; asm("v_cvt_pk_bf16_f32 %0, %1, %2" : "=v"(r) : "v"(lo), "v"(hi)); return r; }
__device__ __forceinline__ float bf_lo(unsigned w) { return __uint_as_float(w << 16); }
__device__ __forceinline__ float bf_hi(unsigned w) { return __uint_as_float(w & 0xffff0000u); }
__device__ __forceinline__ float wave_sum(float v) {
#pragma unroll
    for (int o = 32; o >= 1; o >>= 1) v += __shfl_xor(v, o);
    return v;
}

namespace pg8 {
constexpr int BM = 256, BK = 64, HALF = 128, HTB = HALF * BK * 2, STAGE_BYTES = 8 * HTB, NXCD = 8, WGM = 8;
__host__ __device__ __forceinline__ int lds_byte(int r, int c) { const int st = (r >> 4) * 2 + (c >> 5), rr = r & 15, cc = c & 31, ob = rr * 64 + cc * 2; return st * 1024 + (ob ^ (((ob >> 9) & 1) << 5)); }
__host__ __device__ __forceinline__ void stage_rc(int b, int& R, int& C) { const int st = b / 1024, sb = b % 1024, swz = sb ^ (((sb >> 9) & 1) << 5); R = (st >> 1) * 16 + swz / 64; C = (st & 1) * 32 + (swz % 64) / 2; }
__host__ __device__ __forceinline__ int perm32(int rho) { const int n = rho >> 4, i = rho & 15; return 8 * (i >> 2) + 4 * n + (i & 3); }
struct Unit { int pm, pn; };
struct Gemm { const bf16_t* A; const bf16_t* Bt; int M, N, K; };
struct StaticOrder {
    int nM, nN, nwg, G, c;
    __host__ __device__ void init(int M, int N, int G_, int c_) { nM = M / BM; nN = N / BM; nwg = nM * nN; G = G_; c = c_; }
    __host__ __device__ bool next(int i, Unit& u) const {
        const long L = (long)i * G + c; if (L >= nwg) return false;
        int wgid = (int)L; { const int q = nwg / NXCD, r = nwg % NXCD, xcd = wgid % NXCD, off = wgid / NXCD; wgid = (xcd < r ? xcd * (q + 1) : r * (q + 1) + (xcd - r) * q) + off; }
        const int nig = WGM * nN, gid = wgid / nig, fm = gid * WGM, gsz = (nM - fm) < WGM ? (nM - fm) : WGM;
        u.pm = fm + ((wgid % nig) % gsz); u.pn = (wgid % nig) / gsz; return true;
    }
};
struct PairOrder {
    StaticOrder so;
    __host__ __device__ bool next(int i, Unit& u) const { Unit t; if (!so.next(i >> 1, t)) return false; u.pm = t.pm + (i & 1) * 256; u.pn = t.pn + (i & 1) * 4; return true; }
};
__device__ __forceinline__ f32x2 gelu_pk(f32x2 v) {
    const f32x2 av = __builtin_elementwise_abs(v), d = av * 0.2316418882f + 1.0f;
    f32x2 t; t.x = __builtin_amdgcn_rcpf(d.x); t.y = __builtin_amdgcn_rcpf(d.y);
    f32x2 q = t * 0.5307027145f + (-0.7265760135f); q = q * t + 0.7107068705f; q = q * t + (-0.142248368f); q = q * t + 0.127414796f; q = q * t;
    const f32x2 s = (v * v) * (-0.72134752044f);
    f32x2 e; e.x = __builtin_amdgcn_exp2f(s.x); e.y = __builtin_amdgcn_exp2f(s.y);
    const f32x2 m = v * (q * e), r = v - m;
    f32x2 o; o.x = v.x < 0.f ? m.x : r.x; o.y = v.y < 0.f ? m.y : r.y; return o;
}

template <class Epi, class Sched>
__device__ __forceinline__ void gemm_phase(LAS unsigned char* lds, const Gemm g, const Sched& S, const Epi& E) {
    const int tid = threadIdx.x, wid = __builtin_amdgcn_readfirstlane(tid >> 6), lane = tid & 63, wr = wid >> 2, wc = wid & 3, fr = lane & 15, fq = lane >> 4;
    const int K = g.K, nt = K / BK;
    unsigned voffA[2], voffB[2];
#pragma unroll
    for (int i = 0; i < 2; ++i) { int R, C; stage_rc(tid * 16 + i * 8192, R, C); const int Rb = Epi::PERM ? ((R & ~31) + perm32(R & 31)) : R;
        voffA[i] = (unsigned)(R * K + C) * 2u; voffB[i] = (unsigned)(Rb * K + C) * 2u; }
    const size_t kstep = (size_t)(BK * 2);
    const size_t hstep = (size_t)HALF * K * 2;
    const size_t tstep = 2 * hstep;
    const unsigned ldsw = (unsigned)wid * 1024u;
    const int aoff = lds_byte(wr * 64 + fr, fq * 8), boff = lds_byte(wc * 32 + fr, fq * 8);
#define PG8_SA(b, h) (((b) * 2 + (h)) * HTB)
#define PG8_SB(b, h) ((4 + (b) * 2 + (h)) * HTB)
#define PG8_STAGE(bufoff, gbase, voff) do { _Pragma("unroll") for (int _i = 0; _i < 2; ++_i) \
        __builtin_amdgcn_global_load_lds((const unsigned*)((const char*)(gbase) + (voff)[_i]), (LAS unsigned*)(lds + (bufoff) + ldsw + _i * 8192), 16, 0, 0); } while (0)
#define PG8_LDA(dst, b, h) do { _Pragma("unroll") for (int m = 0; m < 4; ++m) _Pragma("unroll") for (int k = 0; k < 2; ++k) dst[m][k] = *(const LAS bf16x8*)(lds + PG8_SA(b, h) + aoff + m * 2048 + k * 1024); } while (0)
#define PG8_LDB(dst, b, h) do { _Pragma("unroll") for (int n = 0; n < 2; ++n) _Pragma("unroll") for (int k = 0; k < 2; ++k) dst[n][k] = *(const LAS bf16x8*)(lds + PG8_SB(b, h) + boff + n * 2048 + k * 1024); } while (0)
#define PG8_MMA(ai, bj, At, Bt) do { __builtin_amdgcn_s_setprio(1); _Pragma("unroll") for (int m = 0; m < 4; ++m) _Pragma("unroll") for (int n = 0; n < 2; ++n) _Pragma("unroll") for (int k = 0; k < 2; ++k) \
        acc[ai][bj][m][n] = __builtin_amdgcn_mfma_f32_16x16x32_bf16(Bt[n][k], At[m][k], acc[ai][bj][m][n], 0, 0, 0); __builtin_amdgcn_s_setprio(0); } while (0)
#define PG8_WAIT_V(n) asm volatile("s_waitcnt vmcnt(" #n ")" ::: "memory")
#define PG8_WAIT_L(n) asm volatile("s_waitcnt lgkmcnt(" #n ")" ::: "memory")
#define PG8_BAR __builtin_amdgcn_s_barrier()
#define PG8_SCHED __builtin_amdgcn_sched_barrier(0)
    Unit cur, nxt; int ui = 0;
    if (!S.next(0, cur)) return;
    f32x4 acc[2][2][4][2];
#pragma unroll
    for (int a = 0; a < 2; ++a)
#pragma unroll
        for (int b = 0; b < 2; ++b)
#pragma unroll
            for (int m = 0; m < 4; ++m)
#pragma unroll
                for (int n = 0; n < 2; ++n) acc[a][b][m][n] = (f32x4){0.f, 0.f, 0.f, 0.f};
    bf16x8 At[4][2], B0[2][2], B1[2][2];
    const char* cA = (const char*)g.A + (size_t)cur.pm * tstep; const char* cB = (const char*)g.Bt + (size_t)cur.pn * tstep;
    PG8_STAGE(PG8_SB(0, 0), cB, voffB); PG8_STAGE(PG8_SA(0, 0), cA, voffA); PG8_STAGE(PG8_SB(0, 1), cB + hstep, voffB); PG8_STAGE(PG8_SA(0, 1), cA + hstep, voffA);
    if (wr == 1) PG8_BAR;
    PG8_WAIT_V(4); PG8_BAR;
    PG8_STAGE(PG8_SB(1, 0), cB + kstep, voffB); PG8_STAGE(PG8_SA(1, 0), cA + kstep, voffA); PG8_STAGE(PG8_SB(1, 1), cB + hstep + kstep, voffB);
    PG8_WAIT_V(6); PG8_BAR;
    for (;;) {
        const bool has_next = S.next(ui + 1, nxt);
        const char* nA = has_next ? (const char*)g.A + (size_t)nxt.pm * tstep : cA; const char* nB = has_next ? (const char*)g.Bt + (size_t)nxt.pn * tstep : cB;
        for (int t = 0; t < nt; t += 2) {
            const bool last = (t == nt - 2);
            const char* a1 = cA + (size_t)(t + 1) * kstep;
            const char* a2 = last ? nA : cA + (size_t)(t + 2) * kstep; const char* b2 = last ? nB : cB + (size_t)(t + 2) * kstep;
            const char* a3 = a2 + kstep; const char* b3 = b2 + kstep;
            PG8_LDB(B0, 0, 0); PG8_SCHED; PG8_LDA(At, 0, 0); PG8_STAGE(PG8_SA(1, 1), a1 + hstep, voffA);
            PG8_WAIT_L(8); PG8_BAR; PG8_WAIT_L(0); PG8_MMA(0, 0, At, B0); PG8_BAR; PG8_SCHED;
            PG8_LDB(B1, 0, 1); PG8_STAGE(PG8_SB(0, 0), b2, voffB);
            PG8_BAR; PG8_WAIT_L(0); PG8_MMA(0, 1, At, B1); PG8_BAR;
            PG8_LDA(At, 0, 1); PG8_STAGE(PG8_SA(0, 0), a2, voffA);
            PG8_BAR; PG8_WAIT_L(0); PG8_MMA(1, 0, At, B0); PG8_BAR; PG8_SCHED;
            PG8_STAGE(PG8_SB(0, 1), b2 + hstep, voffB);
            PG8_WAIT_V(6); PG8_BAR; PG8_MMA(1, 1, At, B1); PG8_BAR;
            PG8_LDB(B0, 1, 0); PG8_SCHED; PG8_LDA(At, 1, 0); PG8_STAGE(PG8_SA(0, 1), a2 + hstep, voffA);
            PG8_WAIT_L(8); PG8_BAR; PG8_WAIT_L(0); PG8_MMA(0, 0, At, B0); PG8_BAR; PG8_SCHED;
            PG8_LDB(B1, 1, 1); PG8_STAGE(PG8_SB(1, 0), b3, voffB);
            PG8_BAR; PG8_WAIT_L(0); PG8_MMA(0, 1, At, B1); PG8_BAR;
            PG8_LDA(At, 1, 1); PG8_STAGE(PG8_SA(1, 0), a3, voffA);
            PG8_BAR; PG8_WAIT_L(0); PG8_MMA(1, 0, At, B0); PG8_BAR; PG8_SCHED;
            PG8_STAGE(PG8_SB(1, 1), b3 + hstep, voffB);
            PG8_WAIT_V(6); PG8_BAR; PG8_MMA(1, 1, At, B1); PG8_BAR;
        }
        const bool keep_acc = E(acc, cur, wr, wc, fr, fq);
        if (!has_next) break;
        if (!keep_acc)
#pragma unroll
        for (int a = 0; a < 2; ++a)
#pragma unroll
            for (int b = 0; b < 2; ++b)
#pragma unroll
                for (int m = 0; m < 4; ++m)
#pragma unroll
                    for (int n = 0; n < 2; ++n) acc[a][b][m][n] = (f32x4){0.f, 0.f, 0.f, 0.f};
        cur = nxt; cA = nA; cB = nB; ++ui;
    }
    PG8_WAIT_V(0);
    if (wr == 0) PG8_BAR;
    PG8_BAR;
#undef PG8_SA
#undef PG8_SB
#undef PG8_STAGE
#undef PG8_LDA
#undef PG8_LDB
#undef PG8_MMA
#undef PG8_WAIT_V
#undef PG8_WAIT_L
#undef PG8_BAR
#undef PG8_SCHED
}
}

struct EpiProj {
    static constexpr bool PERM = true;
    bf16_t* zuv; bf16_t* qkv; bf16_t* gates;
    __device__ __forceinline__ bool operator()(f32x4 (&acc)[2][2][4][2], const pg8::Unit& u, int wr, int wc, int fr, int fq) const {
        const int row0 = u.pm * 256 + wr * 64 + fr;
        int mode, ldc, colt; bf16_t* base;
        if (u.pn < 8) { mode = 1; base = zuv; ldc = 2048; colt = u.pn * 256; }
        else if (u.pn < 13) { mode = 0; base = qkv; ldc = 1280; colt = (u.pn - 8) * 256; }
        else { mode = 2; base = gates; ldc = 2048; colt = (u.pn - 13) * 256; }
        const int col0 = colt + wc * 32 + 8 * fq;
#pragma unroll
        for (int ai = 0; ai < 2; ++ai)
#pragma unroll
            for (int m = 0; m < 4; ++m) { bf16_t* rowp = base + (size_t)(row0 + ai * 128 + m * 16) * ldc + col0;
#pragma unroll
                for (int bj = 0; bj < 2; ++bj) { f32x4 v0 = acc[ai][bj][m][0], v1 = acc[ai][bj][m][1];
                    if (mode == 1) { f32x2 a = pg8::gelu_pk((f32x2){v0[0], v0[1]}), b = pg8::gelu_pk((f32x2){v0[2], v0[3]}), c = pg8::gelu_pk((f32x2){v1[0], v1[1]}), d = pg8::gelu_pk((f32x2){v1[2], v1[3]});
                        v0 = (f32x4){a.x, a.y, b.x, b.y}; v1 = (f32x4){c.x, c.y, d.x, d.y}; }
                    else if (mode == 2) {
#pragma unroll
                        for (int j = 0; j < 4; ++j) { v0[j] = __builtin_amdgcn_rcpf(1.0f + __expf(-v0[j])); v1[j] = __builtin_amdgcn_rcpf(1.0f + __expf(-v1[j])); } }
                    u32x4 w; w.x = cvt_pk_bf16(v0[0], v0[1]); w.y = cvt_pk_bf16(v0[2], v0[3]); w.z = cvt_pk_bf16(v1[0], v1[1]); w.w = cvt_pk_bf16(v1[2], v1[3]);
                    *(u32x4*)(rowp + bj * 128) = w; } }
        return false;
    }
};
struct EpiMerge {
    static constexpr bool PERM = true;
    const bf16_t* gates; bf16_t* merged;
    __device__ __forceinline__ bool operator()(f32x4 (&acc)[2][2][4][2], const pg8::Unit& u, int wr, int wc, int fr, int fq) const {
        const int which = u.pm >> 8, pm = u.pm & 255, pn = u.pn & 3;
        const int row0 = pm * 256 + wr * 64 + fr, col0 = pn * 256 + wc * 32 + 8 * fq;
#pragma unroll
        for (int ai = 0; ai < 2; ++ai) {
            u32x4 gbw[4][2], gaw[4][2];
#pragma unroll
            for (int m = 0; m < 4; ++m)
#pragma unroll
                for (int bj = 0; bj < 2; ++bj) { const size_t go = (size_t)(row0 + ai * 128 + m * 16) * 2048 + col0 + bj * 128;
                    gbw[m][bj] = *(const u32x4*)(gates + go + 1024); gaw[m][bj] = which == 0 ? *(const u32x4*)(gates + go) : (u32x4){0u, 0u, 0u, 0u}; }
#pragma unroll
            for (int m = 0; m < 4; ++m) { const size_t row = (size_t)(row0 + ai * 128 + m * 16);
#pragma unroll
                for (int bj = 0; bj < 2; ++bj) { const int col = col0 + bj * 128;
                    const u32x4 gb = gbw[m][bj];
                    float gbf[8] = {bf_lo(gb.x), bf_hi(gb.x), bf_lo(gb.y), bf_hi(gb.y), bf_lo(gb.z), bf_hi(gb.z), bf_lo(gb.w), bf_hi(gb.w)};
#pragma unroll
                    for (int j = 0; j < 8; ++j) gbf[j] = fmaxf(gbf[j], 1e-6f);
                    if (which == 0) {
                        const u32x4 ga = gaw[m][bj];
                        const float gaf[8] = {bf_lo(ga.x), bf_hi(ga.x), bf_lo(ga.y), bf_hi(ga.y), bf_lo(ga.z), bf_hi(ga.z), bf_lo(ga.w), bf_hi(ga.w)};
#pragma unroll
                        for (int j = 0; j < 4; ++j) { acc[ai][bj][m][0][j] *= gaf[j] * __builtin_amdgcn_rcpf(gbf[j]); acc[ai][bj][m][1][j] *= gaf[4 + j] * __builtin_amdgcn_rcpf(gbf[4 + j]); }
                    } else {
                        f32x4 v0 = acc[ai][bj][m][0], v1 = acc[ai][bj][m][1];
#pragma unroll
                        for (int j = 0; j < 4; ++j) { v0[j] *= gbf[j]; v1[j] *= gbf[4 + j]; }
                        u32x4 w; w.x = cvt_pk_bf16(v0[0], v0[1]); w.y = cvt_pk_bf16(v0[2], v0[3]); w.z = cvt_pk_bf16(v1[0], v1[1]); w.w = cvt_pk_bf16(v1[2], v1[3]);
                        *(u32x4*)(merged + row * 1024 + col) = w; } } }
        }
        return which == 0;
    }
};
struct EpiY1 {
    static constexpr bool PERM = true;
    const float* x; const float* mod; bf16_t* y1;
    __device__ __forceinline__ bool operator()(f32x4 (&acc)[2][2][4][2], const pg8::Unit& u, int wr, int wc, int fr, int fq) const {
        const int row0 = u.pm * 256 + wr * 64 + fr, col0 = u.pn * 256 + wc * 32 + 8 * fq;
        const int b = (u.pm * 256) >> 13;
        f32x4 gt[2][2];
#pragma unroll
        for (int bj = 0; bj < 2; ++bj)
#pragma unroll
            for (int n = 0; n < 2; ++n) gt[bj][n] = *(const f32x4*)(mod + b * 6144 + 2048 + col0 + bj * 128 + n * 4) + 1.0f;
#pragma unroll
        for (int ai = 0; ai < 2; ++ai)
#pragma unroll
            for (int mp = 0; mp < 2; ++mp) {
                f32x4 xv[2][2][2];
#pragma unroll
                for (int mm = 0; mm < 2; ++mm)
#pragma unroll
                    for (int bj = 0; bj < 2; ++bj) { const size_t off = (size_t)(row0 + ai * 128 + (mp * 2 + mm) * 16) * 1024 + col0 + bj * 128;
                        xv[mm][bj][0] = *(const f32x4*)(x + off); xv[mm][bj][1] = *(const f32x4*)(x + off + 4); }
#pragma unroll
                for (int mm = 0; mm < 2; ++mm)
#pragma unroll
                    for (int bj = 0; bj < 2; ++bj) { const int m = mp * 2 + mm; const size_t off = (size_t)(row0 + ai * 128 + m * 16) * 1024 + col0 + bj * 128;
                        const f32x4 v0 = xv[mm][bj][0] * ALPHA + gt[bj][0] * acc[ai][bj][m][0], v1 = xv[mm][bj][1] * ALPHA + gt[bj][1] * acc[ai][bj][m][1];
                        u32x4 w; w.x = cvt_pk_bf16(v0[0], v0[1]); w.y = cvt_pk_bf16(v0[2], v0[3]); w.z = cvt_pk_bf16(v1[0], v1[1]); w.w = cvt_pk_bf16(v1[2], v1[3]);
                        *(u32x4*)(y1 + off) = w; }
            }
        return false;
    }
};
struct EpiQ {
    static constexpr bool PERM = true;
    bf16_t* q;
    __device__ __forceinline__ bool operator()(f32x4 (&acc)[2][2][4][2], const pg8::Unit& u, int wr, int wc, int fr, int fq) const {
        const int row0 = u.pm * 256 + wr * 64 + fr, col0 = u.pn * 256 + wc * 32 + 8 * fq;
#pragma unroll
        for (int ai = 0; ai < 2; ++ai)
#pragma unroll
            for (int m = 0; m < 4; ++m) { bf16_t* rowp = q + (size_t)(row0 + ai * 128 + m * 16) * 2048 + col0;
#pragma unroll
                for (int bj = 0; bj < 2; ++bj) { const f32x4 v0 = acc[ai][bj][m][0], v1 = acc[ai][bj][m][1];
                    u32x4 w; w.x = cvt_pk_bf16(v0[0], v0[1]); w.y = cvt_pk_bf16(v0[2], v0[3]); w.z = cvt_pk_bf16(v1[0], v1[1]); w.w = cvt_pk_bf16(v1[2], v1[3]);
                    *(u32x4*)(rowp + bj * 128) = w; } }
        return false;
    }
};

struct Args { const float* in[22]; float* out; unsigned char* ws; int ph_lo, ph_hi; };

constexpr float PU_SCALE = 48.0f, PV_SCALE = 7.0f;
typedef float f32x32 __attribute__((ext_vector_type(32)));
typedef _Float16 f16x32 __attribute__((ext_vector_type(32)));
typedef unsigned u32x6 __attribute__((ext_vector_type(6)));
typedef u32x4 u32x4_a8 __attribute__((aligned(8)));
__device__ __forceinline__ void cvt32_fp6(const float* src, unsigned char* dst, size_t i, float sc) {
    f16x32 hv;
#pragma unroll
    for (int q = 0; q < 8; ++q) { const f32x4 a = *(const f32x4*)(src + i * 32 + q * 4) * sc;
        hv[q * 4 + 0] = (_Float16)a[0]; hv[q * 4 + 1] = (_Float16)a[1]; hv[q * 4 + 2] = (_Float16)a[2]; hv[q * 4 + 3] = (_Float16)a[3]; }
    const u32x6 r = __builtin_amdgcn_cvt_scalef32_pk32_fp6_f16(hv, 1.0f);
    unsigned char* q = dst + i * 24;
    *(u32x4_a8*)q = (u32x4){r[0], r[1], r[2], r[3]}; *(u32x2*)(q + 16) = (u32x2){r[4], r[5]};
}
__device__ __forceinline__ void cvt8(const float* src, bf16_t* dst, size_t i) {
    const f32x4 a = *(const f32x4*)(src + i * 8), b = *(const f32x4*)(src + i * 8 + 4);
    u32x4 w; w.x = cvt_pk_bf16(a[0], a[1]); w.y = cvt_pk_bf16(a[2], a[3]); w.z = cvt_pk_bf16(b[0], b[1]); w.w = cvt_pk_bf16(b[2], b[3]);
    *(u32x4*)(dst + i * 8) = w;
}
__device__ __forceinline__ void transpose_tile(const float* W, bf16_t* Wt, int K, int N, int k0, int n0, float* tile  ) {
    const int tid = threadIdx.x;
    __syncthreads();
#pragma unroll
    for (int p = 0; p < 2; ++p) { const int kk = (tid >> 4) + p * 32, n4 = tid & 15;
        const f32x4 v = *(const f32x4*)(W + (size_t)(k0 + kk) * N + n0 + n4 * 4);
        tile[kk * 65 + n4 * 4 + 0] = v[0]; tile[kk * 65 + n4 * 4 + 1] = v[1]; tile[kk * 65 + n4 * 4 + 2] = v[2]; tile[kk * 65 + n4 * 4 + 3] = v[3]; }
    __syncthreads();
    const int nn = tid >> 3, k8 = tid & 7;
    float f[8];
#pragma unroll
    for (int j = 0; j < 8; ++j) f[j] = tile[(k8 * 8 + j) * 65 + nn];
    u32x4 w; w.x = cvt_pk_bf16(f[0], f[1]); w.y = cvt_pk_bf16(f[2], f[3]); w.z = cvt_pk_bf16(f[4], f[5]); w.w = cvt_pk_bf16(f[6], f[7]);
    *(u32x4*)(Wt + (size_t)(n0 + nn) * K + k0 + k8 * 8) = w;
}
__device__ __forceinline__ void p_prep(const Args& a, unsigned char* lds) {
    unsigned char* ws = a.ws;
    const int tid = threadIdx.x, G = gridDim.x, bid = blockIdx.x;
    const size_t gtid = (size_t)bid * 512 + tid, gstride = (size_t)G * 512;
    {
        float* sc = (float*)lds;
        float* part = (float*)(lds + 32768);
        const float* c = a.in[1]; const float* w_ada = a.in[2]; const float* b_ada = a.in[3];
        float* mod = (float*)(ws + WS_MOD);
        for (int i = tid; i < 8192; i += 512) { const float v = c[i]; sc[i] = v / (1.0f + __expf(-v)); }
        __syncthreads();
        for (int task = bid; task < 256; task += G) {
            const int cg3 = tid & 7, ks = tid >> 3, n0 = task * 24 + cg3 * 3;
            float acc[8][3];
#pragma unroll
            for (int b = 0; b < 8; ++b) { acc[b][0] = 0.f; acc[b][1] = 0.f; acc[b][2] = 0.f; }
#pragma unroll 4
            for (int kk = 0; kk < 16; ++kk) { const int k = ks * 16 + kk;
                const float w0 = w_ada[(size_t)k * 6144 + n0], w1 = w_ada[(size_t)k * 6144 + n0 + 1], w2 = w_ada[(size_t)k * 6144 + n0 + 2];
#pragma unroll
                for (int b = 0; b < 8; ++b) { const float s = sc[b * 1024 + k]; acc[b][0] += s * w0; acc[b][1] += s * w1; acc[b][2] += s * w2; } }
            __syncthreads();
#pragma unroll
            for (int b = 0; b < 8; ++b)
#pragma unroll
                for (int j = 0; j < 3; ++j) part[(ks * 8 + b) * 24 + cg3 * 3 + j] = acc[b][j];
            __syncthreads();
            if (tid < 192) { const int b = tid / 24, cc = tid % 24; float s = 0.f;
                for (int k2 = 0; k2 < 64; ++k2) s += part[(k2 * 8 + b) * 24 + cc];
                mod[b * 6144 + task * 24 + cc] = s + b_ada[task * 24 + cc]; }
        }
        __syncthreads();
    }
    {
        float* tile = (float*)lds;
        for (int tl = bid; tl < 2624; tl += G) {
            const float* W; bf16_t* Wt; int N, idx;
            if (tl < 1344) { W = a.in[4]; Wt = (bf16_t*)(ws + WS_WIN); N = 5376; idx = tl; }
            else if (tl < 1600) { W = a.in[10]; Wt = (bf16_t*)(ws + WS_WAB); N = 1024; idx = tl - 1344; }
            else if (tl < 1856) { W = a.in[11]; Wt = (bf16_t*)(ws + WS_WAB) + (size_t)1024 * 1024; N = 1024; idx = tl - 1600; }
            else if (tl < 2112) { W = a.in[12]; Wt = (bf16_t*)(ws + WS_WOUT); N = 1024; idx = tl - 1856; }
            else { W = a.in[15]; Wt = (bf16_t*)(ws + WS_WPQ); N = 2048; idx = tl - 2112; }
            const int nN = N / 64, kt = idx / nN, ntile = idx % nN;
            transpose_tile(W, Wt, 1024, N, kt * 64, ntile * 64, tile);
        }
        __syncthreads();
    }
    {
        const float* pu = a.in[18]; const float* pv = a.in[19];
        bf16_t* PU = (bf16_t*)(ws + WS_PU); bf16_t* PV = (bf16_t*)(ws + WS_PV);
        const size_t n32 = (size_t)16384 * 1024 / 32;
        for (size_t i = gtid; i < n32; i += gstride) { cvt32_fp6(pu, (unsigned char*)PU, i, PU_SCALE); cvt32_fp6(pv, (unsigned char*)PV, i, PV_SCALE); }
        bf16_t* SK = (bf16_t*)(ws + WS_SK);
        for (size_t i = gtid; i < 131072 / 8; i += gstride) { cvt8(a.in[16], SK, i); cvt8(a.in[17], SK + 131072, i); }
        bf16_t* WSP = (bf16_t*)(ws + WS_WSP); const float* wsp = a.in[7];
        for (size_t i = gtid; i < 131072 / 8; i += gstride) {
            const int e0 = (int)i * 8, s0 = e0 & 127, t = (e0 >> 7) & 127;
            f32x4 x0 = *(const f32x4*)(wsp + e0), x1 = *(const f32x4*)(wsp + e0 + 4);
#pragma unroll
            for (int j = 0; j < 4; ++j) { if (s0 + j > t) x0[j] = 0.f; if (s0 + 4 + j > t) x1[j] = 0.f; }
            u32x4 w; w.x = cvt_pk_bf16(x0[0], x0[1]); w.y = cvt_pk_bf16(x0[2], x0[3]); w.z = cvt_pk_bf16(x1[0], x1[1]); w.w = cvt_pk_bf16(x1[2], x1[3]);
            *(u32x4*)(WSP + e0) = w;
        }
    }
}

__device__ __forceinline__ void p_h(const Args& a) {
    const float* x = a.in[0]; const float* mod = (const float*)(a.ws + WS_MOD); bf16_t* H = (bf16_t*)(a.ws + WS_AO);
    const size_t gtid = (size_t)blockIdx.x * 512 + threadIdx.x, gstride = (size_t)gridDim.x * 512;
    for (size_t i = gtid; i < (size_t)T * D / 8; i += gstride) {
        const size_t e = i * 8; const int col = (int)(e & 1023), b = (int)(e >> 23);
        const float* mp = mod + b * 6144;
        const f32x4 x0 = *(const f32x4*)(x + e), x1 = *(const f32x4*)(x + e + 4);
        const f32x4 s0 = *(const f32x4*)(mp + 1024 + col), s1 = *(const f32x4*)(mp + 1024 + col + 4);
        const f32x4 h0 = *(const f32x4*)(mp + col), h1 = *(const f32x4*)(mp + col + 4);
        const f32x4 r0 = x0 * (s0 + 1.0f) + h0, r1 = x1 * (s1 + 1.0f) + h1;
        u32x4 w; w.x = cvt_pk_bf16(r0[0], r0[1]); w.y = cvt_pk_bf16(r0[2], r0[3]); w.z = cvt_pk_bf16(r1[0], r1[1]); w.w = cvt_pk_bf16(r1[2], r1[3]);
        *(u32x4*)(H + e) = w;
    }
}

__device__ __forceinline__ void p_gmlp(const Args& a, unsigned char* lds) {
    const bf16_t* ZUV = (const bf16_t*)(a.ws + WS_ZUV); bf16_t* AO = (bf16_t*)(a.ws + WS_AO);
    const bf16_t* WSP = (const bf16_t*)(a.ws + WS_WSP);
    const float* lnv_g = a.in[5]; const float* lnv_b = a.in[6]; const float* b_sp = a.in[8];
    const int tid = threadIdx.x, lane = tid & 63, wid = tid >> 6, g4 = lane >> 4, l15 = lane & 15;
    constexpr int VS = 272;
    unsigned char* VnT = lds;
    float* stats = (float*)(lds + 36864);
    for (int ch = blockIdx.x; ch < 512; ch += gridDim.x) {
        const size_t t0 = (size_t)ch * 128;
        __syncthreads();
#pragma unroll 1
        for (int r8 = 0; r8 < 16; r8 += 8) {
            u32x4 p0[8], p1[8];
#pragma unroll
            for (int r = 0; r < 8; ++r) { const bf16_t* vp = ZUV + (t0 + wid * 16 + r8 + r) * 2048 + 1024; p0[r] = *(const u32x4*)(vp + lane * 8); p1[r] = *(const u32x4*)(vp + 512 + lane * 8); }
#pragma unroll
            for (int r = 0; r < 8; ++r) { const int s = wid * 16 + r8 + r;
                float f[16] = {bf_lo(p0[r].x), bf_hi(p0[r].x), bf_lo(p0[r].y), bf_hi(p0[r].y), bf_lo(p0[r].z), bf_hi(p0[r].z), bf_lo(p0[r].w), bf_hi(p0[r].w),
                               bf_lo(p1[r].x), bf_hi(p1[r].x), bf_lo(p1[r].y), bf_hi(p1[r].y), bf_lo(p1[r].z), bf_hi(p1[r].z), bf_lo(p1[r].w), bf_hi(p1[r].w)};
                float sm = 0.f;
#pragma unroll
                for (int j = 0; j < 16; ++j) sm += f[j];
                const float mu = wave_sum(sm) * (1.0f / 1024.0f);
                float q = 0.f;
#pragma unroll
                for (int j = 0; j < 16; ++j) { const float d = f[j] - mu; q += d * d; }
                const float var = wave_sum(q) * (1.0f / 1024.0f);
                if (lane == 0) { stats[s * 2] = mu; stats[s * 2 + 1] = rsqrtf(var + LN_EPS); }
            }
        }
        __syncthreads();
        for (int g = 0; g < 8; ++g) {
            { const int d8 = tid & 15;
              u32x4 pv[4];
#pragma unroll
              for (int i = 0; i < 4; ++i) pv[i] = *(const u32x4*)(ZUV + (t0 + (tid >> 4) + 32 * i) * 2048 + 1024 + g * 128 + d8 * 8);
              const f32x4 ga = *(const f32x4*)(lnv_g + g * 128 + d8 * 8), gb = *(const f32x4*)(lnv_g + g * 128 + d8 * 8 + 4);
              const f32x4 ba = *(const f32x4*)(lnv_b + g * 128 + d8 * 8), bb = *(const f32x4*)(lnv_b + g * 128 + d8 * 8 + 4);
              const float gg[8] = {ga[0], ga[1], ga[2], ga[3], gb[0], gb[1], gb[2], gb[3]};
              const float bbv[8] = {ba[0], ba[1], ba[2], ba[3], bb[0], bb[1], bb[2], bb[3]};
#pragma unroll
              for (int i = 0; i < 4; ++i) { const int s = (tid >> 4) + 32 * i; const u32x4 p = pv[i];
                const float mu = stats[s * 2], rs = stats[s * 2 + 1];
                float f[8] = {bf_lo(p.x), bf_hi(p.x), bf_lo(p.y), bf_hi(p.y), bf_lo(p.z), bf_hi(p.z), bf_lo(p.w), bf_hi(p.w)};
#pragma unroll
                for (int j = 0; j < 8; j += 2) { const float y0 = (f[j] - mu) * rs * gg[j] + bbv[j], y1 = (f[j + 1] - mu) * rs * gg[j + 1] + bbv[j + 1];
                    const unsigned w = cvt_pk_bf16(y0, y1);
                    *(bf16_t*)(VnT + (d8 * 8 + j) * VS + d8 * 16 + s * 2) = (bf16_t)(w & 0xffffu);
                    *(bf16_t*)(VnT + (d8 * 8 + j + 1) * VS + d8 * 16 + s * 2) = (bf16_t)(w >> 16); }
              } }
            __syncthreads();
            f32x4 acc[8];
#pragma unroll
            for (int db = 0; db < 8; ++db) acc[db] = (f32x4){0.f, 0.f, 0.f, 0.f};
            const int tl = wid * 16 + l15;
            const int nkc = (wid * 16 + 15) / 32 + 1;
            bf16x8 bw[4];
#pragma unroll
            for (int kc = 0; kc < 4; ++kc) bw[kc] = *(const bf16x8*)(WSP + ((size_t)g * 128 + tl) * 128 + (kc < nkc ? kc : 0) * 32 + g4 * 8);
            const float bs = b_sp[g * 128 + tl];
            const bf16_t* up = ZUV + (t0 + tl) * 2048 + g * 128 + g4 * 4;
            u32x2 uw[8];
#pragma unroll
            for (int db = 0; db < 8; ++db) uw[db] = *(const u32x2*)(up + db * 16);
#pragma unroll
            for (int kc = 0; kc < 4; ++kc) {
                if (kc < nkc) {
#pragma unroll
                    for (int db = 0; db < 8; ++db) {
                        const bf16x8 av = *(const bf16x8*)(VnT + (db * 16 + l15) * VS + (db * 2 + (l15 >> 3)) * 16 + (kc * 32 + g4 * 8) * 2);
                        acc[db] = __builtin_amdgcn_mfma_f32_16x16x32_bf16(av, bw[kc], acc[db], 0, 0, 0);
                    }
                }
            }
            bf16_t* ap = AO + (t0 + tl) * 1024 + g * 128 + g4 * 4;
#pragma unroll
            for (int db = 0; db < 8; ++db) {
                const float r0 = bf_lo(uw[db].x) * (acc[db][0] + bs), r1 = bf_hi(uw[db].x) * (acc[db][1] + bs), r2 = bf_lo(uw[db].y) * (acc[db][2] + bs), r3 = bf_hi(uw[db].y) * (acc[db][3] + bs);
                u32x2 ow; ow.x = cvt_pk_bf16(r0, r1); ow.y = cvt_pk_bf16(r2, r3);
                *(u32x2*)(ap + db * 16) = ow;
            }
            __syncthreads();
        }
    }
}

__device__ __forceinline__ void p_attn(const Args& a, unsigned char* lds) {
    const bf16_t* QKV = (const bf16_t*)(a.ws + WS_QKV); bf16_t* O = (bf16_t*)(a.ws + WS_AO) + (size_t)T * 1024;
    const float* sinks = a.in[9];
    const int tid = threadIdx.x, lane = tid & 63, wid = tid >> 6, g4 = lane >> 4, l15 = lane & 15;
    constexpr int KS = 144, VTS = 528;
    unsigned char* Ks = lds;
    unsigned char* Vt = lds + 36864;
    for (int tl = blockIdx.x; tl < 1024; tl += gridDim.x) {
        const int kvh = tl & 1, n = (tl >> 1) & 63, b = tl >> 7;
        const long tq0 = (long)b * SEQ + (long)n * 128;
        const long tk0 = tq0 - 128;
        __syncthreads();
#pragma unroll
        for (int i = 0; i < 4; ++i) { const int idx = tid + 512 * i, j = idx >> 3, c8 = idx & 7;
            u32x4 kw = (u32x4){0u, 0u, 0u, 0u}, vw = (u32x4){0u, 0u, 0u, 0u};
            if (n > 0 || j >= 128) { const bf16_t* rp = QKV + (size_t)(tk0 + j) * 1280;
                kw = *(const u32x4*)(rp + 1024 + kvh * 64 + c8 * 8); vw = *(const u32x4*)(rp + 1152 + kvh * 64 + c8 * 8); }
            *(u32x4*)(Ks + j * KS + c8 * 16) = kw;
            const unsigned vv[4] = {vw.x, vw.y, vw.z, vw.w};
#pragma unroll
            for (int e = 0; e < 4; ++e) { *(bf16_t*)(Vt + (c8 * 8 + 2 * e) * VTS + c8 * 16 + j * 2) = (bf16_t)(vv[e] & 0xffffu); *(bf16_t*)(Vt + (c8 * 8 + 2 * e + 1) * VTS + c8 * 16 + j * 2) = (bf16_t)(vv[e] >> 16); }
        }
        __syncthreads();
        const int hq = kvh * 8 + wid;
        const float sink = sinks[hq];
        bf16x8 nq0, nq1;
        { const bf16_t* qp = QKV + (size_t)(tq0 + l15) * 1280 + hq * 64 + g4 * 8; nq0 = *(const bf16x8*)qp; nq1 = *(const bf16x8*)(qp + 32); }
#pragma unroll 1
        for (int rb = 0; rb < 8; ++rb) {
            const long tq = tq0 + rb * 16 + l15;
            const bf16x8 q0 = nq0, q1 = nq1;
            if (rb < 7) { const bf16_t* qp = QKV + (size_t)(tq + 16) * 1280 + hq * 64 + g4 * 8; nq0 = *(const bf16x8*)qp; nq1 = *(const bf16x8*)(qp + 32); }
            const int kb0 = rb & ~1;
            f32x4 s[10];
#pragma unroll
            for (int kbi = 0; kbi < 10; ++kbi) { const int kb = kb0 + kbi;
                const bf16x8 k0 = *(const bf16x8*)(Ks + (kb * 16 + l15) * KS + g4 * 16), k1 = *(const bf16x8*)(Ks + (kb * 16 + l15) * KS + 64 + g4 * 16);
                f32x4 c = (f32x4){0.f, 0.f, 0.f, 0.f};
                c = __builtin_amdgcn_mfma_f32_16x16x32_bf16(k0, q0, c, 0, 0, 0);
                c = __builtin_amdgcn_mfma_f32_16x16x32_bf16(k1, q1, c, 0, 0, 0);
                s[kbi] = c; }
            const int qi = rb * 16 + l15 + 128;
            float mx = sink;
#pragma unroll
            for (int kbi = 0; kbi < 10; ++kbi)
#pragma unroll
                for (int r = 0; r < 4; ++r) { const int ki = (kb0 + kbi) * 16 + g4 * 4 + r;
                    const bool valid = (ki <= qi) && (ki > qi - 128) && (n > 0 || ki >= 128);
                    const float v = valid ? s[kbi][r] * 0.125f : -1e30f; s[kbi][r] = v; mx = fmaxf(mx, v); }
            mx = fmaxf(mx, __shfl_xor(mx, 16)); mx = fmaxf(mx, __shfl_xor(mx, 32));
            float l = 0.f;
#pragma unroll
            for (int kbi = 0; kbi < 10; ++kbi)
#pragma unroll
                for (int r = 0; r < 4; ++r) { const float p = __expf(s[kbi][r] - mx); s[kbi][r] = p; l += p; }
            l += __shfl_xor(l, 16); l += __shfl_xor(l, 32);
            l += __expf(sink - mx);
            const float inv = 1.0f / l;
            f32x4 o[4];
#pragma unroll
            for (int db = 0; db < 4; ++db) o[db] = (f32x4){0.f, 0.f, 0.f, 0.f};
#pragma unroll
            for (int c = 0; c < 5; ++c) {
                u32x4 pw; pw.x = cvt_pk_bf16(s[2 * c][0], s[2 * c][1]); pw.y = cvt_pk_bf16(s[2 * c][2], s[2 * c][3]);
                pw.z = cvt_pk_bf16(s[2 * c + 1][0], s[2 * c + 1][1]); pw.w = cvt_pk_bf16(s[2 * c + 1][2], s[2 * c + 1][3]);
                const bf16x8 pb = __builtin_bit_cast(bf16x8, pw);
                const int key0 = (kb0 + 2 * c) * 16 + g4 * 4;
#pragma unroll
                for (int db = 0; db < 4; ++db) {
                    const u32x2 va = *(const u32x2*)(Vt + (db * 16 + l15) * VTS + (db * 2 + (l15 >> 3)) * 16 + key0 * 2), vb = *(const u32x2*)(Vt + (db * 16 + l15) * VTS + (db * 2 + (l15 >> 3)) * 16 + (key0 + 16) * 2);
                    u32x4 vw; vw.x = va.x; vw.y = va.y; vw.z = vb.x; vw.w = vb.y;
                    o[db] = __builtin_amdgcn_mfma_f32_16x16x32_bf16(__builtin_bit_cast(bf16x8, vw), pb, o[db], 0, 0, 0);
                }
            }
            bf16_t* op = O + (size_t)tq * 1024 + hq * 64 + g4 * 4;
#pragma unroll
            for (int db = 0; db < 4; ++db) { u32x2 ow; ow.x = cvt_pk_bf16(o[db][0] * inv, o[db][1] * inv); ow.y = cvt_pk_bf16(o[db][2] * inv, o[db][3] * inv);
                *(u32x2*)(op + db * 16) = ow; }
        }
    }
}

__device__ __forceinline__ void p_ln1(const Args& a) {
    const bf16_t* Y1 = (const bf16_t*)(a.ws + WS_ZUV); const float* mod = (const float*)(a.ws + WS_MOD);
    float* stats = (float*)(a.ws + WS_STATS); bf16_t* H2 = (bf16_t*)(a.ws + WS_QKV);
    const float* g1 = a.in[13]; const float* b1 = a.in[14];
    const int lane = threadIdx.x & 63; const int gw = blockIdx.x * 8 + (threadIdx.x >> 6), nw = gridDim.x * 8;
    float gg[16], bb[16];
#pragma unroll
    for (int h = 0; h < 2; ++h)
#pragma unroll
        for (int j = 0; j < 8; ++j) { gg[h * 8 + j] = g1[h * 512 + lane * 8 + j]; bb[h * 8 + j] = b1[h * 512 + lane * 8 + j]; }
    int t = gw; if (t >= T) return;
    u32x4 n0 = *(const u32x4*)(Y1 + (size_t)t * 1024 + lane * 8), n1 = *(const u32x4*)(Y1 + (size_t)t * 1024 + 512 + lane * 8);
    for (; t < T; t += nw) {
        const u32x4 p0 = n0, p1 = n1;
        const int tn = t + nw < T ? t + nw : t;
        n0 = *(const u32x4*)(Y1 + (size_t)tn * 1024 + lane * 8); n1 = *(const u32x4*)(Y1 + (size_t)tn * 1024 + 512 + lane * 8);
        const int b = t >> 13; const float* mp = mod + b * 6144;
        float v[16] = {bf_lo(p0.x), bf_hi(p0.x), bf_lo(p0.y), bf_hi(p0.y), bf_lo(p0.z), bf_hi(p0.z), bf_lo(p0.w), bf_hi(p0.w),
                       bf_lo(p1.x), bf_hi(p1.x), bf_lo(p1.y), bf_hi(p1.y), bf_lo(p1.z), bf_hi(p1.z), bf_lo(p1.w), bf_hi(p1.w)};
        float sm = 0.f;
#pragma unroll
        for (int j = 0; j < 16; ++j) sm += v[j];
        const float mu = wave_sum(sm) * (1.0f / 1024.0f);
        float q = 0.f;
#pragma unroll
        for (int j = 0; j < 16; ++j) { const float d = v[j] - mu; q += d * d; }
        const float rs = rsqrtf(wave_sum(q) * (1.0f / 1024.0f) + LN_EPS);
        if (lane == 0) { stats[t * 2] = mu; stats[t * 2 + 1] = rs; }
#pragma unroll
        for (int h = 0; h < 2; ++h) { const int col = h * 512 + lane * 8; float r[8];
            const f32x4 sc0 = *(const f32x4*)(mp + 4096 + col), sc1 = *(const f32x4*)(mp + 4096 + col + 4), sh0 = *(const f32x4*)(mp + 3072 + col), sh1 = *(const f32x4*)(mp + 3072 + col + 4);
#pragma unroll
            for (int j = 0; j < 8; ++j) { const float x1v = (v[h * 8 + j] - mu) * rs * gg[h * 8 + j] + bb[h * 8 + j]; r[j] = x1v * (1.0f + (j < 4 ? sc0[j] : sc1[j - 4])) + (j < 4 ? sh0[j] : sh1[j - 4]); }
            u32x4 w; w.x = cvt_pk_bf16(r[0], r[1]); w.y = cvt_pk_bf16(r[2], r[3]); w.z = cvt_pk_bf16(r[4], r[5]); w.w = cvt_pk_bf16(r[6], r[7]);
            *(u32x4*)(H2 + (size_t)t * 1024 + col) = w; }
    }
}

__device__ __forceinline__ unsigned ordf(float f) { const unsigned b = __float_as_uint(f); return b ^ ((unsigned)((int)b >> 31) | 0x80000000u); }
__device__ __forceinline__ float unordf(unsigned u) { const unsigned b = (u & 0x80000000u) ? (u ^ 0x80000000u) : ~u; return __uint_as_float(b); }
__device__ __forceinline__ void bitonic_sort16(unsigned (&k)[16]) {
#pragma unroll
    for (int size = 2; size <= 16; size <<= 1) {
#pragma unroll
        for (int stride = size >> 1; stride >= 1; stride >>= 1) {
#pragma unroll
            for (int i = 0; i < 16; ++i) { const int l = i ^ stride;
                if (l > i) { const bool desc = ((i & size) == 0); const unsigned hi = max(k[i], k[l]), lo = min(k[i], k[l]); k[i] = desc ? hi : lo; k[l] = desc ? lo : hi; } }
        }
    }
}
__device__ __forceinline__ void bitonic_merge16(unsigned (&k)[16]) {
#pragma unroll
    for (int stride = 8; stride >= 1; stride >>= 1) {
#pragma unroll
        for (int i = 0; i < 16; ++i) { const int l = i ^ stride;
            if (l > i) { const unsigned hi = max(k[i], k[l]), lo = min(k[i], k[l]); k[i] = hi; k[l] = lo; } }
    }
}
__device__ __forceinline__ void merge_across4(unsigned (&c)[16]) {
#pragma unroll
    for (int lv = 16; lv <= 32; lv <<= 1) {
        unsigned p[16];
#pragma unroll
        for (int i = 0; i < 16; ++i) p[i] = (unsigned)__shfl_xor((int)c[15 - i], lv);
#pragma unroll
        for (int i = 0; i < 16; ++i) c[i] = max(c[i], p[i]);
        bitonic_merge16(c);
    }
}
__device__ __forceinline__ void peer_half_scores(const unsigned char* SKl  , const bf16x8 (&qf)[4], int l15, int g4, unsigned (&sel)[16]) {
    unsigned ka[16], kb2[16];
#pragma unroll
    for (int kb = 0; kb < 8; ++kb) { f32x4 c = (f32x4){0.f, 0.f, 0.f, 0.f};
#pragma unroll
        for (int ks = 0; ks < 4; ++ks) { const bf16x8 kf = *(const bf16x8*)(SKl + (kb * 16 + l15) * 272 + ks * 64 + g4 * 16);
            c = __builtin_amdgcn_mfma_f32_16x16x32_bf16(kf, qf[ks], c, 0, 0, 0); }
#pragma unroll
        for (int r = 0; r < 4; ++r) { const unsigned kk = (ordf(c[r]) & ~127u) | (unsigned)(kb * 16 + g4 * 4 + r);
            if (kb < 4) ka[kb * 4 + r] = kk; else kb2[(kb - 4) * 4 + r] = kk; }
        if (kb & 1) __builtin_amdgcn_sched_barrier(0); }
    bitonic_sort16(ka); bitonic_sort16(kb2);
#pragma unroll
    for (int i = 0; i < 16; ++i) sel[i] = max(ka[i], kb2[15 - i]);
    bitonic_merge16(sel);
    merge_across4(sel);
}
__host__ __device__ constexpr int cand_i(int g, int s) { return g == 0 ? 0 : g == 1 ? (s < 8 ? 1 : s < 13 ? 2 : 3) : g == 2 ? (s == 0 ? 3 : s < 4 ? 4 : s < 6 ? 5 : s < 8 ? 6 : s < 10 ? 7 : s - 2) : (s == 0 ? 14 : 15); }
__host__ __device__ constexpr int cand_j(int g, int s) { return g == 0 ? s : g == 1 ? (s < 8 ? s : s < 13 ? s - 8 : s - 13) : g == 2 ? (s == 0 ? 3 : s < 4 ? s - 1 : s < 6 ? s - 4 : s < 8 ? s - 6 : s < 10 ? s - 8 : 0) : 0; }

__device__ __forceinline__ void p_topk(const Args& a, unsigned char* lds) {
    const bf16_t* Q = (const bf16_t*)(a.ws + WS_GATES); const bf16_t* SK = (const bf16_t*)(a.ws + WS_SK);
    int* IDX = (int*)(a.ws + WS_IDX); float* WGT = (float*)(a.ws + WS_WGT);
    const int tid = threadIdx.x, lane = tid & 63, wid = tid >> 6, g4 = lane >> 4, l15 = lane & 15;
    for (int unit = blockIdx.x; unit < 256; unit += gridDim.x) {
        const int h = unit & 7, c = unit >> 3;
        __syncthreads();
#pragma unroll
        for (int i = 0; i < 8; ++i) { const int idx = tid + 512 * i, half = idx >> 11, row = (idx >> 4) & 127, pc = idx & 15;
            const u32x4 v = *(const u32x4*)(SK + (size_t)half * 131072 + (size_t)h * 16384 + row * 128 + pc * 8);
            *(u32x4*)(lds + half * 34816 + row * 272 + pc * 16) = v; }
        __syncthreads();
      for (int it = 0; it < 16; ++it) {
        const int tb = c * 128 + it * 8 + wid;
        const size_t t = (size_t)tb * 16 + l15;
        bf16x8 q1[4], q2[4];
        { const bf16_t* qp = Q + t * 2048 + h * 256 + g4 * 8;
#pragma unroll
          for (int ks = 0; ks < 4; ++ks) { q1[ks] = *(const bf16x8*)(qp + ks * 32); q2[ks] = *(const bf16x8*)(qp + 128 + ks * 32); } }
        unsigned sel1[16], sel2[16];
        peer_half_scores(lds, q1, l15, g4, sel1);
        peer_half_scores(lds + 34816, q2, l15, g4, sel2);
        unsigned ck[16];
#pragma unroll
        for (int s = 0; s < 16; ++s) {
            const unsigned s1 = g4 == 0 ? sel1[cand_i(0, s)] : g4 == 1 ? sel1[cand_i(1, s)] : g4 == 2 ? sel1[cand_i(2, s)] : sel1[cand_i(3, s)];
            const unsigned s2 = g4 == 0 ? sel2[cand_j(0, s)] : g4 == 1 ? sel2[cand_j(1, s)] : g4 == 2 ? sel2[cand_j(2, s)] : sel2[cand_j(3, s)];
            const float sm = unordf(s1 & ~127u) + unordf(s2 & ~127u);
            const unsigned kk = (ordf(sm) & 0xFFFFC000u) | ((s1 & 127u) << 7) | (s2 & 127u);
            ck[s] = (g4 < 3 || s < 2) ? kk : 0u;
        }
        bitonic_sort16(ck);
        merge_across4(ck);
        float wsc[16];
        const float mx0 = unordf(ck[0] & 0xFFFFC000u); float sum = 0.f;
#pragma unroll
        for (int rd = 0; rd < 16; ++rd) { wsc[rd] = __expf(unordf(ck[rd] & 0xFFFFC000u) - mx0); sum += wsc[rd]; }
        const float inv = 1.0f / sum;
        if (g4 == 0) {
            int* ip = IDX + t * 128 + h * 16; float* wp = WGT + t * 128 + h * 16;
#pragma unroll
            for (int q4 = 0; q4 < 4; ++q4) {
                *(u32x4*)(ip + q4 * 4) = (u32x4){ck[q4 * 4] & 0x3FFFu, ck[q4 * 4 + 1] & 0x3FFFu, ck[q4 * 4 + 2] & 0x3FFFu, ck[q4 * 4 + 3] & 0x3FFFu};
                *(f32x4*)(wp + q4 * 4) = (f32x4){wsc[q4 * 4] * inv, wsc[q4 * 4 + 1] * inv, wsc[q4 * 4 + 2] * inv, wsc[q4 * 4 + 3] * inv};
            }
        }
      }
    }
}

template <int CTRL> __device__ __forceinline__ float dpp_f(float v) { return __builtin_bit_cast(float, __builtin_amdgcn_update_dpp(0, __builtin_bit_cast(int, v), CTRL, 0xF, 0xF, true)); }
__device__ __forceinline__ f32x32 fp6x32(const u32x4 a, const u32x2 b) { const u32x6 v = {a.x, a.y, a.z, a.w, b.x, b.y}; return __builtin_amdgcn_cvt_scalef32_pk32_f32_fp6(v, 1.0f); }
__device__ __forceinline__ void p_gdot(const Args& a) {
    const unsigned char* ws = a.ws;
    const bf16_t* H2 = (const bf16_t*)(ws + WS_QKV); const int* IDX = (const int*)(ws + WS_IDX); float* WGT = (float*)(ws + WS_WGT);
    const unsigned char* PU = ws + WS_PU;
    const int lane = threadIdx.x & 63, l31 = lane & 31; const int gw = blockIdx.x * 8 + (threadIdx.x >> 6), nw = gridDim.x * 8;
    const bool up32 = (lane & 32) != 0, up16 = (lane & 16) != 0, up8 = (lane & 8) != 0;
    const int ebi = 2 * (2 * (up16 ? 1 : 0) + (up8 ? 1 : 0)) + (up32 ? 1 : 0);
    int t = gw;
    int ev0 = 0, ev1 = 0; float wv0 = 0.f, wv1 = 0.f;
    if (t < T) { ev0 = IDX[(size_t)t * 128 + lane]; ev1 = IDX[(size_t)t * 128 + 64 + lane]; wv0 = WGT[(size_t)t * 128 + lane]; wv1 = WGT[(size_t)t * 128 + 64 + lane]; }
#define U_LOADX(U4, U2, E0, E1, kbase) do { const int _evs = (kbase) < 64 ? E0 : E1; _Pragma("unroll") for (int s = 0; s < 4; ++s) { \
        const int e0 = __builtin_amdgcn_readlane(_evs, ((kbase) & 63) + 2 * s), e1 = __builtin_amdgcn_readlane(_evs, ((kbase) & 63) + 2 * s + 1); const int e = up32 ? e1 : e0; \
        const unsigned char* up = PU + (size_t)e * 768 + l31 * 24; U4[s] = *(const u32x4_a8*)up; U2[s] = *(const u32x2*)(up + 16); } } while (0)
#define U_COMP(U4, U2, kbase) do { float d[4]; \
        _Pragma("unroll") for (int s = 0; s < 4; ++s) { const f32x32 uf = fp6x32(U4[s], U2[s]); f32x2 sacc = (f32x2){uf[0], uf[1]} * hf[0]; \
            _Pragma("unroll") for (int i = 1; i < 16; ++i) sacc += (f32x2){uf[2 * i], uf[2 * i + 1]} * hf[i]; d[s] = sacc.x + sacc.y; } \
        float k2[2]; _Pragma("unroll") for (int j = 0; j < 2; ++j) { const float snd = up16 ? d[j] : d[j + 2], keep = up16 ? d[j + 2] : d[j]; k2[j] = keep + __shfl_xor(snd, 16); } \
        float r = (up8 ? k2[1] : k2[0]) + dpp_f<0x140>(up8 ? k2[0] : k2[1]); \
        r += dpp_f<0x141>(r); r += dpp_f<0x4E>(r); r += dpp_f<0xB1>(r); \
        const float wsel = __shfl((kbase) < 64 ? wv0 : wv1, ((kbase) & 63) + ebi); \
        const float x = r * (1.0f / PU_SCALE); const float cv = 0.5f * x * (1.0f + erff(x * 0.70710678118f)) * wsel * (1.0f / PV_SCALE); \
        if ((lane & 7) == 0) cp[(kbase) + ebi] = cv; } while (0)
    u32x4 UA4[4], UB4[4]; u32x2 UA2[4], UB2[4]; u32x4 hr[4];
#pragma unroll
    for (int q = 0; q < 4; ++q) hr[q] = (u32x4){0u, 0u, 0u, 0u};
    if (t < T) { U_LOADX(UA4, UA2, ev0, ev1, 0);
#pragma unroll
        for (int q = 0; q < 4; ++q) hr[q] = *(const u32x4*)(H2 + (size_t)t * 1024 + l31 * 32 + q * 8); }
    for (; t < T; t += nw) {
        f32x2 hf[16];
#pragma unroll
        for (int q = 0; q < 4; ++q) { hf[q * 4 + 0] = (f32x2){bf_lo(hr[q].x), bf_hi(hr[q].x)}; hf[q * 4 + 1] = (f32x2){bf_lo(hr[q].y), bf_hi(hr[q].y)};
            hf[q * 4 + 2] = (f32x2){bf_lo(hr[q].z), bf_hi(hr[q].z)}; hf[q * 4 + 3] = (f32x2){bf_lo(hr[q].w), bf_hi(hr[q].w)}; }
        const int tn = t + nw < T ? t + nw : t;
        const int nev0 = IDX[(size_t)tn * 128 + lane], nev1 = IDX[(size_t)tn * 128 + 64 + lane]; const float nwv0 = WGT[(size_t)tn * 128 + lane], nwv1 = WGT[(size_t)tn * 128 + 64 + lane];
#pragma unroll
        for (int q = 0; q < 4; ++q) hr[q] = *(const u32x4*)(H2 + (size_t)tn * 1024 + l31 * 32 + q * 8);
        float* cp = WGT + (size_t)t * 128;
#pragma unroll 1
        for (int b2 = 0; b2 < 8; ++b2) {
            U_LOADX(UB4, UB2, ev0, ev1, 16 * b2 + 8);
            U_COMP(UA4, UA2, 16 * b2);
            if (b2 < 7) U_LOADX(UA4, UA2, ev0, ev1, 16 * b2 + 16); else U_LOADX(UA4, UA2, nev0, nev1, 0);
            U_COMP(UB4, UB2, 16 * b2 + 8);
        }
        ev0 = nev0; ev1 = nev1; wv0 = nwv0; wv1 = nwv1;
    }
#undef U_LOADX
#undef U_COMP
}

__device__ __forceinline__ void p_gather(const Args& a) {
    const unsigned char* ws = a.ws;
    const bf16_t* Y1 = (const bf16_t*)(ws + WS_ZUV); const float* stats = (const float*)(ws + WS_STATS); const float* mod = (const float*)(ws + WS_MOD);
    const int* IDX = (const int*)(ws + WS_IDX); const float* WGT = (const float*)(ws + WS_WGT);
    const unsigned char* PV = ws + WS_PV;
    const float* g1 = a.in[13]; const float* b1 = a.in[14]; const float* g2 = a.in[20]; const float* b2 = a.in[21];
    const int lane = threadIdx.x & 63, l31 = lane & 31; const int gw = blockIdx.x * 8 + (threadIdx.x >> 6), nw = gridDim.x * 8;
    const bool up32 = (lane & 32) != 0;
    int t = gw;
    int ev0 = 0, ev1 = 0; float wv0 = 0.f, wv1 = 0.f;
    if (t < T) { ev0 = IDX[(size_t)t * 128 + lane]; ev1 = IDX[(size_t)t * 128 + 64 + lane]; wv0 = WGT[(size_t)t * 128 + lane]; wv1 = WGT[(size_t)t * 128 + 64 + lane]; }
#define V_LOADX(V4, V2, E0, E1, kbase) do { const int _evs = (kbase) < 64 ? E0 : E1; _Pragma("unroll") for (int s = 0; s < 4; ++s) { \
        const int e0 = __builtin_amdgcn_readlane(_evs, ((kbase) & 63) + 2 * s), e1 = __builtin_amdgcn_readlane(_evs, ((kbase) & 63) + 2 * s + 1); const int e = up32 ? e1 : e0; \
        const unsigned char* vp = PV + (size_t)e * 768 + l31 * 24; V4[s] = *(const u32x4_a8*)vp; V2[s] = *(const u32x2*)(vp + 16); } } while (0)
#define V_COMP(V4, V2, kbase) do { const int _wvs = __builtin_bit_cast(int, (kbase) < 64 ? wv0 : wv1); _Pragma("unroll") for (int s = 0; s < 4; ++s) { \
        const float c0 = __builtin_bit_cast(float, __builtin_amdgcn_readlane(_wvs, ((kbase) & 63) + 2 * s)), c1 = __builtin_bit_cast(float, __builtin_amdgcn_readlane(_wvs, ((kbase) & 63) + 2 * s + 1)); \
        const float cj = up32 ? c1 : c0; const f32x2 cc = (f32x2){cj, cj}; const f32x32 vf = fp6x32(V4[s], V2[s]); \
        _Pragma("unroll") for (int i = 0; i < 16; ++i) acc[i] += cc * (f32x2){vf[2 * i], vf[2 * i + 1]}; } } while (0)
    u32x4 VA4[4], VB4[4]; u32x2 VA2[4], VB2[4];
    if (t < T) V_LOADX(VA4, VA2, ev0, ev1, 0);
    for (; t < T; t += nw) {
        f32x2 acc[16];
#pragma unroll
        for (int j = 0; j < 16; ++j) acc[j] = (f32x2){0.f, 0.f};
        const int tn = t + nw < T ? t + nw : t;
        const int nev0 = IDX[(size_t)tn * 128 + lane], nev1 = IDX[(size_t)tn * 128 + 64 + lane]; const float nwv0 = WGT[(size_t)tn * 128 + lane], nwv1 = WGT[(size_t)tn * 128 + 64 + lane];
        const int colp = l31 * 32 + (up32 ? 16 : 0);
        u32x2 ywp[4];
#pragma unroll
        for (int q4 = 0; q4 < 4; ++q4) ywp[q4] = *(const u32x2*)(Y1 + (size_t)t * 1024 + colp + q4 * 4);
        const float mu1 = stats[t * 2], rs1 = stats[t * 2 + 1];
#pragma unroll 1
        for (int b2 = 0; b2 < 8; ++b2) {
            V_LOADX(VB4, VB2, ev0, ev1, 16 * b2 + 8);
            V_COMP(VA4, VA2, 16 * b2);
            if (b2 < 7) V_LOADX(VA4, VA2, ev0, ev1, 16 * b2 + 16); else V_LOADX(VA4, VA2, nev0, nev1, 0);
            V_COMP(VB4, VB2, 16 * b2 + 8);
        }
        float f[16];
#pragma unroll
        for (int j = 0; j < 8; ++j) {
            const float s0 = up32 ? acc[j].x : acc[8 + j].x, s1 = up32 ? acc[j].y : acc[8 + j].y;
            const float r0 = __shfl_xor(s0, 32), r1 = __shfl_xor(s1, 32);
            f[2 * j] = (up32 ? acc[8 + j].x : acc[j].x) + r0; f[2 * j + 1] = (up32 ? acc[8 + j].y : acc[j].y) + r1; }
        const int b = t >> 13; const float* mp = mod + b * 6144 + 5120;
        const int col = colp;
        float y[16];
#pragma unroll
        for (int q4 = 0; q4 < 4; ++q4) { const u32x2 yw = ywp[q4]; const f32x4 yv = (f32x4){bf_lo(yw.x), bf_hi(yw.x), bf_lo(yw.y), bf_hi(yw.y)};
            const f32x4 gg = *(const f32x4*)(g1 + col + q4 * 4), bb = *(const f32x4*)(b1 + col + q4 * 4), gt = *(const f32x4*)(mp + col + q4 * 4);
#pragma unroll
            for (int j = 0; j < 4; ++j) { const float x1v = (yv[j] - mu1) * rs1 * gg[j] + bb[j]; y[q4 * 4 + j] = ALPHA * x1v + (1.0f + gt[j]) * f[q4 * 4 + j]; } }
        float sm = 0.f;
#pragma unroll
        for (int j = 0; j < 16; ++j) sm += y[j];
        const float mu = wave_sum(sm) * (1.0f / 1024.0f);
        float q = 0.f;
#pragma unroll
        for (int j = 0; j < 16; ++j) { const float dd = y[j] - mu; q += dd * dd; }
        const float rs = rsqrtf(wave_sum(q) * (1.0f / 1024.0f) + LN_EPS);
#pragma unroll
        for (int q4 = 0; q4 < 4; ++q4) { const f32x4 gg = *(const f32x4*)(g2 + col + q4 * 4), bb = *(const f32x4*)(b2 + col + q4 * 4); f32x4 o;
#pragma unroll
            for (int j = 0; j < 4; ++j) o[j] = (y[q4 * 4 + j] - mu) * rs * gg[j] + bb[j];
            *(f32x4*)(a.out + (size_t)t * 1024 + col + q4 * 4) = o; }
        ev0 = nev0; ev1 = nev1; wv0 = nwv0; wv1 = nwv1;
    }
#undef V_LOADX
#undef V_COMP
}

#define XB_TMO      128
#define XB_XCNT(j)  (256  + 64 * (j))
#define XB_XSUB(j)  (1280 + 64 * (j))
#define XB_XGEN(j)  (2304 + 64 * (j))
#define XB_TOP      3328
#define XB_TOPGEN   3392
#define XCD_BAR_WORDS 3456
#define XB_SPIN_CAP (1u << 18)
__device__ __forceinline__ unsigned xb_ld(unsigned* p)              { return __hip_atomic_load(p, __ATOMIC_RELAXED, __HIP_MEMORY_SCOPE_AGENT); }
__device__ __forceinline__ unsigned xb_add(unsigned* p, unsigned v) { return __hip_atomic_fetch_add(p, v, __ATOMIC_RELAXED, __HIP_MEMORY_SCOPE_AGENT); }
__device__ __forceinline__ unsigned xb_xcc_id() { return (unsigned)__builtin_amdgcn_s_getreg((3 << 11) | 20) & 0xFu; }
#define XB_SPIN(cond, bar) do { unsigned _sp = 0; while (cond) { __builtin_amdgcn_s_sleep(1); \
    if ((++_sp & 255u) == 0u) { if (xb_ld(&(bar)[XB_TMO])) break; if (_sp > XB_SPIN_CAP) { atomicAdd(&(bar)[XB_TMO], 1u); break; } } } } while (0)
struct XcdBarrier { unsigned* bar; unsigned x; volatile LAS unsigned* st; };
__device__ __forceinline__ XcdBarrier xcd_barrier_post(unsigned* bar, volatile LAS unsigned* st) {
    XcdBarrier b; b.bar = bar; b.x = xb_xcc_id(); b.st = st;
    if (threadIdx.x == 0) (void)xb_add(&bar[XB_XCNT(b.x)], 1u);
    return b;
}
__device__ __forceinline__ void xcd_barrier_complete(unsigned* bar, unsigned x, unsigned& nloc, unsigned& nx) {
    const unsigned G = gridDim.x * gridDim.y * gridDim.z;
    unsigned sum, cnt, mine, sp = 0u;
    for (;;) {
        sum = 0u; cnt = 0u; mine = 0u;
#pragma unroll
        for (unsigned j = 0; j < 16; ++j) { const unsigned c = xb_ld(&bar[XB_XCNT(j)]); sum += c; cnt += (c > 0u) ? 1u : 0u; mine = (j == x) ? c : mine; }
        if (sum == G) break;
        __builtin_amdgcn_s_sleep(1);
        if ((++sp & 255u) == 0u) { if (xb_ld(&bar[XB_TMO])) break; if (sp > XB_SPIN_CAP) { atomicAdd(&bar[XB_TMO], 1u); break; } }
    }
    nloc = mine > 0u ? mine : 1u; nx = cnt > 0u ? cnt : 1u;
}
__device__ __forceinline__ void xcd_barrier(const XcdBarrier& b) {
    asm volatile("s_waitcnt vmcnt(0)" ::: "memory");
    __syncthreads();
    if (threadIdx.x == 0) {
        unsigned* bar = b.bar;
        __builtin_amdgcn_s_waitcnt(0);
        unsigned nloc = b.st[0], nx = b.st[1];
        if (nloc == 0u) { xcd_barrier_complete(bar, b.x, nloc, nx); b.st[0] = nloc; b.st[1] = nx; }
        const unsigned old = xb_add(&bar[XB_XSUB(b.x)], 1u);
        const unsigned gen = old / nloc;
        if (old + 1u == (gen + 1u) * nloc) {
            __builtin_amdgcn_fence(__ATOMIC_RELEASE, "agent");
            asm volatile("s_waitcnt vmcnt(0)" ::: "memory");
            const unsigned og = xb_add(&bar[XB_TOP], 1u);
            const unsigned tg = og / nx;
            if (og + 1u == (tg + 1u) * nx) xb_add(&bar[XB_TOPGEN], 1u);
            else XB_SPIN(xb_ld(&bar[XB_TOPGEN]) == tg, bar);
            __builtin_amdgcn_fence(__ATOMIC_ACQUIRE, "agent");
            xb_add(&bar[XB_XGEN(b.x)], 1u);
            asm volatile("s_waitcnt vmcnt(0)" ::: "memory");
        } else {
            XB_SPIN(xb_ld(&bar[XB_XGEN(b.x)]) == gen, bar);
            __builtin_amdgcn_fence(__ATOMIC_ACQUIRE, "agent");
            asm volatile("s_waitcnt vmcnt(0)" ::: "memory");
        }
    }
    __syncthreads();
}

constexpr int NPHASE = 11;
constexpr int LDS_BYTES = 128 * 1024 + 1024;

#ifndef REPEAT_MASK
#define REPEAT_MASK 0
#endif
__global__ void __launch_bounds__(512) mega(Args a) {
    extern __shared__ __attribute__((aligned(16))) unsigned char lds[];
    cg::grid_group grid = cg::this_grid();
    const int lo = a.ph_lo, hi = a.ph_hi;
    unsigned char* ws = a.ws;
    const int G = gridDim.x;
    XcdBarrier xbar; xbar.bar = (unsigned*)(ws + WS_BAR); xbar.x = 0; xbar.st = (volatile LAS unsigned*)((LAS unsigned char*)lds + 131072);
    if (hi - lo > 1) {
        if (threadIdx.x < 4) ((LAS unsigned*)((LAS unsigned char*)lds + 131072))[threadIdx.x] = 0u;
        __syncthreads();
        xbar = xcd_barrier_post((unsigned*)(ws + WS_BAR), (volatile LAS unsigned*)((LAS unsigned char*)lds + 131072));
    }
#define IN(k) (lo <= (k) && (k) < hi)
#define PH(k, ...) do { if (IN(k)) { __VA_ARGS__; if ((REPEAT_MASK >> (k)) & 1) { grid.sync(); __VA_ARGS__; } } if (IN(k) && IN((k) + 1)) { if ((k) == 0) grid.sync(); else xcd_barrier(xbar); } } while (0)
    PH(0, p_prep(a, lds));
    PH(1, p_h(a));
    PH(2, {
        pg8::Gemm g{(const bf16_t*)(ws + WS_AO), (const bf16_t*)(ws + WS_WIN), T, 5376, 1024}; pg8::StaticOrder S; S.init(T, 5376, G, (int)blockIdx.x);
        EpiProj E{(bf16_t*)(ws + WS_ZUV), (bf16_t*)(ws + WS_QKV), (bf16_t*)(ws + WS_GATES)};
        pg8::gemm_phase((LAS unsigned char*)lds, g, S, E); });
    PH(3, { p_gmlp(a, lds); __syncthreads(); p_attn(a, lds); });
    PH(4, {
        pg8::Gemm g{(const bf16_t*)(ws + WS_AO), (const bf16_t*)(ws + WS_WAB), 2 * T, 2048, 1024}; pg8::PairOrder S; S.so.init(T, 1024, G, (int)blockIdx.x);
        EpiMerge E{(const bf16_t*)(ws + WS_GATES), (bf16_t*)(ws + WS_QKV)};
        pg8::gemm_phase((LAS unsigned char*)lds, g, S, E); });
    PH(5, {
        pg8::Gemm g{(const bf16_t*)(ws + WS_QKV), (const bf16_t*)(ws + WS_WOUT), T, 1024, 1024}; pg8::StaticOrder S; S.init(T, 1024, G, (int)blockIdx.x);
        EpiY1 E{a.in[0], (const float*)(ws + WS_MOD), (bf16_t*)(ws + WS_ZUV)};
        pg8::gemm_phase((LAS unsigned char*)lds, g, S, E); });
    PH(6, p_ln1(a));
    PH(7, {
        pg8::Gemm g{(const bf16_t*)(ws + WS_QKV), (const bf16_t*)(ws + WS_WPQ), T, 2048, 1024}; pg8::StaticOrder S; S.init(T, 2048, G, (int)blockIdx.x);
        EpiQ E{(bf16_t*)(ws + WS_GATES)};
        pg8::gemm_phase((LAS unsigned char*)lds, g, S, E); });
    PH(8, p_topk(a, lds));
    PH(9, p_gdot(a));
    PH(10, p_gather(a));
#undef IN
#undef PH
}

extern "C" void kernel_launch(void* const* d_in, const int* in_sizes, int n_in, void* d_out, int out_size, void* d_ws, size_t ws_size, hipStream_t stream) {
    static int grid = 0;
    if (grid == 0) {
        if (n_in != 22 || ws_size < WS_END) { fprintf(stderr, "kernel_launch: unexpected n_in %d or ws_size %zu (< %zu)\n", n_in, ws_size, (size_t)WS_END); grid = -1; return; }
        int dev = 0, cus = 0, per_cu = 0;
        (void)hipGetDevice(&dev); (void)hipDeviceGetAttribute(&cus, hipDeviceAttributeMultiprocessorCount, dev);
        if (hipFuncSetAttribute((const void*)mega, hipFuncAttributeMaxDynamicSharedMemorySize, LDS_BYTES) != hipSuccess) { fprintf(stderr, "kernel_launch: hipFuncSetAttribute failed\n"); grid = -1; return; }
        if (hipOccupancyMaxActiveBlocksPerMultiprocessor(&per_cu, (const void*)mega, 512, LDS_BYTES) != hipSuccess || per_cu < 1) { fprintf(stderr, "kernel_launch: occupancy query says %d\n", per_cu); per_cu = 1; }
        (void)hipGetLastError();
        grid = cus > 0 ? cus : 256;
    }
    if (grid < 0) return;
    Args a{};
    for (int i = 0; i < 22; ++i) a.in[i] = (const float*)d_in[i];
    a.out = (float*)d_out; a.ws = (unsigned char*)d_ws;
#if ONE_LAUNCH
    if (hipMemsetAsync((char*)d_ws + WS_BAR, 0, XCD_BAR_WORDS * sizeof(unsigned), stream) != hipSuccess) { fprintf(stderr, "kernel_launch: memset of the barrier words failed\n"); return; }
    a.ph_lo = 0; a.ph_hi = NPHASE;
    void* args[] = {&a};
    hipError_t e = hipLaunchCooperativeKernel((const void*)mega, dim3(grid), dim3(512), args, LDS_BYTES, stream);
    if (e != hipSuccess) fprintf(stderr, "cooperative launch failed: %s (grid %d)\n", hipGetErrorString(e), grid);
#else
    for (int p = 0; p < NPHASE; ++p) { a.ph_lo = p; a.ph_hi = p + 1; hipLaunchKernelGGL(mega, dim3(grid), dim3(512), LDS_BYTES, stream, a); }
#endif
}
```

```cpp
#include <hip/hip_runtime.h>
#include <hip/hip_cooperative_groups.h>
#include <cstdio>
namespace cg = cooperative_groups;

#ifndef ONE_LAUNCH
#define ONE_LAUNCH 1
#endif

#define LAS __attribute__((address_space(3)))
typedef unsigned short bf16_t;
typedef short bf16x8 __attribute__((ext_vector_type(8)));
typedef float f32x4 __attribute__((ext_vector_type(4)));
typedef float f32x2 __attribute__((ext_vector_type(2)));
typedef unsigned u32x4 __attribute__((ext_vector_type(4)));
typedef unsigned u32x2 __attribute__((ext_vector_type(2)));

constexpr int T = 65536, D = 1024, SEQ = 8192;
constexpr size_t MiB = 1ull << 20;
constexpr size_t WS_ZUV = 0;
constexpr size_t WS_QKV = 256 * MiB;
constexpr size_t WS_GATES = 416 * MiB;
constexpr size_t WS_AO = 672 * MiB;
constexpr size_t WS_IDX = WS_AO;
constexpr size_t WS_WGT = WS_AO + 32 * MiB;
constexpr size_t WS_WIN = 928 * MiB;
constexpr size_t WS_WAB = WS_WIN + (size_t)5376 * 1024 * 2;
constexpr size_t WS_WOUT = WS_WAB + 4 * MiB;
constexpr size_t WS_WPQ = WS_WOUT + 2 * MiB;
constexpr size_t WS_SK = WS_WPQ + 4 * MiB;
constexpr size_t WS_WSP = WS_SK + 512 * 1024;
constexpr size_t WS_PU = WS_WSP + 256 * 1024;
constexpr size_t WS_PV = WS_PU + 32 * MiB;
constexpr size_t WS_MOD = WS_PV + 32 * MiB;
constexpr size_t WS_STATS = WS_MOD + 256 * 1024;
constexpr size_t WS_BAR = WS_STATS + 512 * 1024;
constexpr size_t WS_END = WS_BAR + 16 * 1024;

constexpr float ALPHA = 1.18920711500272f;
constexpr float LN_EPS = 1e-5f;

__device__ __forceinline__ unsigned cvt_pk_bf16(float lo, float hi) { unsigned r; asm("v_cvt_pk_bf16_f32 %0, %1, %2" : "=v"(r) : "v"(lo), "v"(hi)); return r; }
__device__ __forceinline__ float bf_lo(unsigned w) { return __uint_as_float(w << 16); }
__device__ __forceinline__ float bf_hi(unsigned w) { return __uint_as_float(w & 0xffff0000u); }
__device__ __forceinline__ float wave_sum(float v) {
#pragma unroll
    for (int o = 32; o >= 1; o >>= 1) v += __shfl_xor(v, o);
    return v;
}

namespace pg8 {
constexpr int BM = 256, BK = 64, HALF = 128, HTB = HALF * BK * 2, STAGE_BYTES = 8 * HTB, NXCD = 8, WGM = 8;
__host__ __device__ __forceinline__ int lds_byte(int r, int c) { const int st = (r >> 4) * 2 + (c >> 5), rr = r & 15, cc = c & 31, ob = rr * 64 + cc * 2; return st * 1024 + (ob ^ (((ob >> 9) & 1) << 5)); }
__host__ __device__ __forceinline__ void stage_rc(int b, int& R, int& C) { const int st = b / 1024, sb = b % 1024, swz = sb ^ (((sb >> 9) & 1) << 5); R = (st >> 1) * 16 + swz / 64; C = (st & 1) * 32 + (swz % 64) / 2; }
__host__ __device__ __forceinline__ int perm32(int rho) { const int n = rho >> 4, i = rho & 15; return 8 * (i >> 2) + 4 * n + (i & 3); }
struct Unit { int pm, pn; };
struct Gemm { const bf16_t* A; const bf16_t* Bt; int M, N, K; };
struct StaticOrder {
    int nM, nN, nwg, G, c;
    __host__ __device__ void init(int M, int N, int G_, int c_) { nM = M / BM; nN = N / BM; nwg = nM * nN; G = G_; c = c_; }
    __host__ __device__ bool next(int i, Unit& u) const {
        const long L = (long)i * G + c; if (L >= nwg) return false;
        int wgid = (int)L; { const int q = nwg / NXCD, r = nwg % NXCD, xcd = wgid % NXCD, off = wgid / NXCD; wgid = (xcd < r ? xcd * (q + 1) : r * (q + 1) + (xcd - r) * q) + off; }
        const int nig = WGM * nN, gid = wgid / nig, fm = gid * WGM, gsz = (nM - fm) < WGM ? (nM - fm) : WGM;
        u.pm = fm + ((wgid % nig) % gsz); u.pn = (wgid % nig) / gsz; return true;
    }
};
struct PairOrder {
    StaticOrder so;
    __host__ __device__ bool next(int i, Unit& u) const { Unit t; if (!so.next(i >> 1, t)) return false; u.pm = t.pm + (i & 1) * 256; u.pn = t.pn + (i & 1) * 4; return true; }
};
__device__ __forceinline__ f32x2 gelu_pk(f32x2 v) {
    const f32x2 av = __builtin_elementwise_abs(v), d = av * 0.2316418882f + 1.0f;
    f32x2 t; t.x = __builtin_amdgcn_rcpf(d.x); t.y = __builtin_amdgcn_rcpf(d.y);
    f32x2 q = t * 0.5307027145f + (-0.7265760135f); q = q * t + 0.7107068705f; q = q * t + (-0.142248368f); q = q * t + 0.127414796f; q = q * t;
    const f32x2 s = (v * v) * (-0.72134752044f);
    f32x2 e; e.x = __builtin_amdgcn_exp2f(s.x); e.y = __builtin_amdgcn_exp2f(s.y);
    const f32x2 m = v * (q * e), r = v - m;
    f32x2 o; o.x = v.x < 0.f ? m.x : r.x; o.y = v.y < 0.f ? m.y : r.y; return o;
}

template <class Epi, class Sched>
__device__ __forceinline__ void gemm_phase(LAS unsigned char* lds, const Gemm g, const Sched& S, const Epi& E) {
    const int tid = threadIdx.x, wid = __builtin_amdgcn_readfirstlane(tid >> 6), lane = tid & 63, wr = wid >> 2, wc = wid & 3, fr = lane & 15, fq = lane >> 4;
    const int K = g.K, nt = K / BK;
    unsigned voffA[2], voffB[2];
#pragma unroll
    for (int i = 0; i < 2; ++i) { int R, C; stage_rc(tid * 16 + i * 8192, R, C); const int Rb = Epi::PERM ? ((R & ~31) + perm32(R & 31)) : R;
        voffA[i] = (unsigned)(R * K + C) * 2u; voffB[i] = (unsigned)(Rb * K + C) * 2u; }
    const size_t kstep = (size_t)(BK * 2);
    const size_t hstep = (size_t)HALF * K * 2;
    const size_t tstep = 2 * hstep;
    const unsigned ldsw = (unsigned)wid * 1024u;
    const int aoff = lds_byte(wr * 64 + fr, fq * 8), boff = lds_byte(wc * 32 + fr, fq * 8);
#define PG8_SA(b, h) (((b) * 2 + (h)) * HTB)
#define PG8_SB(b, h) ((4 + (b) * 2 + (h)) * HTB)
#define PG8_STAGE(bufoff, gbase, voff) do { _Pragma("unroll") for (int _i = 0; _i < 2; ++_i) \
        __builtin_amdgcn_global_load_lds((const unsigned*)((const char*)(gbase) + (voff)[_i]), (LAS unsigned*)(lds + (bufoff) + ldsw + _i * 8192), 16, 0, 0); } while (0)
#define PG8_LDA(dst, b, h) do { _Pragma("unroll") for (int m = 0; m < 4; ++m) _Pragma("unroll") for (int k = 0; k < 2; ++k) dst[m][k] = *(const LAS bf16x8*)(lds + PG8_SA(b, h) + aoff + m * 2048 + k * 1024); } while (0)
#define PG8_LDB(dst, b, h) do { _Pragma("unroll") for (int n = 0; n < 2; ++n) _Pragma("unroll") for (int k = 0; k < 2; ++k) dst[n][k] = *(const LAS bf16x8*)(lds + PG8_SB(b, h) + boff + n * 2048 + k * 1024); } while (0)
#define PG8_MMA(ai, bj, At, Bt) do { __builtin_amdgcn_s_setprio(1); _Pragma("unroll") for (int m = 0; m < 4; ++m) _Pragma("unroll") for (int n = 0; n < 2; ++n) _Pragma("unroll") for (int k = 0; k < 2; ++k) \
        acc[ai][bj][m][n] = __builtin_amdgcn_mfma_f32_16x16x32_bf16(Bt[n][k], At[m][k], acc[ai][bj][m][n], 0, 0, 0); __builtin_amdgcn_s_setprio(0); } while (0)
#define PG8_WAIT_V(n) asm volatile("s_waitcnt vmcnt(" #n ")" ::: "memory")
#define PG8_WAIT_L(n) asm volatile("s_waitcnt lgkmcnt(" #n ")" ::: "memory")
#define PG8_BAR __builtin_amdgcn_s_barrier()
#define PG8_SCHED __builtin_amdgcn_sched_barrier(0)
    Unit cur, nxt; int ui = 0;
    if (!S.next(0, cur)) return;
    f32x4 acc[2][2][4][2];
#pragma unroll
    for (int a = 0; a < 2; ++a)
#pragma unroll
        for (int b = 0; b < 2; ++b)
#pragma unroll
            for (int m = 0; m < 4; ++m)
#pragma unroll
                for (int n = 0; n < 2; ++n) acc[a][b][m][n] = (f32x4){0.f, 0.f, 0.f, 0.f};
    bf16x8 At[4][2], B0[2][2], B1[2][2];
    const char* cA = (const char*)g.A + (size_t)cur.pm * tstep; const char* cB = (const char*)g.Bt + (size_t)cur.pn * tstep;
    PG8_STAGE(PG8_SB(0, 0), cB, voffB); PG8_STAGE(PG8_SA(0, 0), cA, voffA); PG8_STAGE(PG8_SB(0, 1), cB + hstep, voffB); PG8_STAGE(PG8_SA(0, 1), cA + hstep, voffA);
    if (wr == 1) PG8_BAR;
    PG8_WAIT_V(4); PG8_BAR;
    PG8_STAGE(PG8_SB(1, 0), cB + kstep, voffB); PG8_STAGE(PG8_SA(1, 0), cA + kstep, voffA); PG8_STAGE(PG8_SB(1, 1), cB + hstep + kstep, voffB);
    PG8_WAIT_V(6); PG8_BAR;
    for (;;) {
        const bool has_next = S.next(ui + 1, nxt);
        const char* nA = has_next ? (const char*)g.A + (size_t)nxt.pm * tstep : cA; const char* nB = has_next ? (const char*)g.Bt + (size_t)nxt.pn * tstep : cB;
        for (int t = 0; t < nt; t += 2) {
            const bool last = (t == nt - 2);
            const char* a1 = cA + (size_t)(t + 1) * kstep;
            const char* a2 = last ? nA : cA + (size_t)(t + 2) * kstep; const char* b2 = last ? nB : cB + (size_t)(t + 2) * kstep;
            const char* a3 = a2 + kstep; const char* b3 = b2 + kstep;
            PG8_LDB(B0, 0, 0); PG8_SCHED; PG8_LDA(At, 0, 0); PG8_STAGE(PG8_SA(1, 1), a1 + hstep, voffA);
            PG8_WAIT_L(8); PG8_BAR; PG8_WAIT_L(0); PG8_MMA(0, 0, At, B0); PG8_BAR; PG8_SCHED;
            PG8_LDB(B1, 0, 1); PG8_STAGE(PG8_SB(0, 0), b2, voffB);
            PG8_BAR; PG8_WAIT_L(0); PG8_MMA(0, 1, At, B1); PG8_BAR;
            PG8_LDA(At, 0, 1); PG8_STAGE(PG8_SA(0, 0), a2, voffA);
            PG8_BAR; PG8_WAIT_L(0); PG8_MMA(1, 0, At, B0); PG8_BAR; PG8_SCHED;
            PG8_STAGE(PG8_SB(0, 1), b2 + hstep, voffB);
            PG8_WAIT_V(6); PG8_BAR; PG8_MMA(1, 1, At, B1); PG8_BAR;
            PG8_LDB(B0, 1, 0); PG8_SCHED; PG8_LDA(At, 1, 0); PG8_STAGE(PG8_SA(0, 1), a2 + hstep, voffA);
            PG8_WAIT_L(8); PG8_BAR; PG8_WAIT_L(0); PG8_MMA(0, 0, At, B0); PG8_BAR; PG8_SCHED;
            PG8_LDB(B1, 1, 1); PG8_STAGE(PG8_SB(1, 0), b3, voffB);
            PG8_BAR; PG8_WAIT_L(0); PG8_MMA(0, 1, At, B1); PG8_BAR;
            PG8_LDA(At, 1, 1); PG8_STAGE(PG8_SA(1, 0), a3, voffA);
            PG8_BAR; PG8_WAIT_L(0); PG8_MMA(1, 0, At, B0); PG8_BAR; PG8_SCHED;
            PG8_STAGE(PG8_SB(1, 1), b3 + hstep, voffB);
            PG8_WAIT_V(6); PG8_BAR; PG8_MMA(1, 1, At, B1); PG8_BAR;
        }
        const bool keep_acc = E(acc, cur, wr, wc, fr, fq);
        if (!has_next) break;
        if (!keep_acc)
#pragma unroll
        for (int a = 0; a < 2; ++a)
#pragma unroll
            for (int b = 0; b < 2; ++b)
#pragma unroll
                for (int m = 0; m < 4; ++m)
#pragma unroll
                    for (int n = 0; n < 2; ++n) acc[a][b][m][n] = (f32x4){0.f, 0.f, 0.f, 0.f};
        cur = nxt; cA = nA; cB = nB; ++ui;
    }
    PG8_WAIT_V(0);
    if (wr == 0) PG8_BAR;
    PG8_BAR;
#undef PG8_SA
#undef PG8_SB
#undef PG8_STAGE
#undef PG8_LDA
#undef PG8_LDB
#undef PG8_MMA
#undef PG8_WAIT_V
#undef PG8_WAIT_L
#undef PG8_BAR
#undef PG8_SCHED
}
}

struct EpiProj {
    static constexpr bool PERM = true;
    bf16_t* zuv; bf16_t* qkv; bf16_t* gates;
    __device__ __forceinline__ bool operator()(f32x4 (&acc)[2][2][4][2], const pg8::Unit& u, int wr, int wc, int fr, int fq) const {
        const int row0 = u.pm * 256 + wr * 64 + fr;
        int mode, ldc, colt; bf16_t* base;
        if (u.pn < 8) { mode = 1; base = zuv; ldc = 2048; colt = u.pn * 256; }
        else if (u.pn < 13) { mode = 0; base = qkv; ldc = 1280; colt = (u.pn - 8) * 256; }
        else { mode = 2; base = gates; ldc = 2048; colt = (u.pn - 13) * 256; }
        const int col0 = colt + wc * 32 + 8 * fq;
#pragma unroll
        for (int ai = 0; ai < 2; ++ai)
#pragma unroll
            for (int m = 0; m < 4; ++m) { bf16_t* rowp = base + (size_t)(row0 + ai * 128 + m * 16) * ldc + col0;
#pragma unroll
                for (int bj = 0; bj < 2; ++bj) { f32x4 v0 = acc[ai][bj][m][0], v1 = acc[ai][bj][m][1];
                    if (mode == 1) { f32x2 a = pg8::gelu_pk((f32x2){v0[0], v0[1]}), b = pg8::gelu_pk((f32x2){v0[2], v0[3]}), c = pg8::gelu_pk((f32x2){v1[0], v1[1]}), d = pg8::gelu_pk((f32x2){v1[2], v1[3]});
                        v0 = (f32x4){a.x, a.y, b.x, b.y}; v1 = (f32x4){c.x, c.y, d.x, d.y}; }
                    else if (mode == 2) {
#pragma unroll
                        for (int j = 0; j < 4; ++j) { v0[j] = __builtin_amdgcn_rcpf(1.0f + __expf(-v0[j])); v1[j] = __builtin_amdgcn_rcpf(1.0f + __expf(-v1[j])); } }
                    u32x4 w; w.x = cvt_pk_bf16(v0[0], v0[1]); w.y = cvt_pk_bf16(v0[2], v0[3]); w.z = cvt_pk_bf16(v1[0], v1[1]); w.w = cvt_pk_bf16(v1[2], v1[3]);
                    *(u32x4*)(rowp + bj * 128) = w; } }
        return false;
    }
};
struct EpiMerge {
    static constexpr bool PERM = true;
    const bf16_t* gates; bf16_t* merged;
    __device__ __forceinline__ bool operator()(f32x4 (&acc)[2][2][4][2], const pg8::Unit& u, int wr, int wc, int fr, int fq) const {
        const int which = u.pm >> 8, pm = u.pm & 255, pn = u.pn & 3;
        const int row0 = pm * 256 + wr * 64 + fr, col0 = pn * 256 + wc * 32 + 8 * fq;
#pragma unroll
        for (int ai = 0; ai < 2; ++ai) {
            u32x4 gbw[4][2], gaw[4][2];
#pragma unroll
            for (int m = 0; m < 4; ++m)
#pragma unroll
                for (int bj = 0; bj < 2; ++bj) { const size_t go = (size_t)(row0 + ai * 128 + m * 16) * 2048 + col0 + bj * 128;
                    gbw[m][bj] = *(const u32x4*)(gates + go + 1024); gaw[m][bj] = which == 0 ? *(const u32x4*)(gates + go) : (u32x4){0u, 0u, 0u, 0u}; }
#pragma unroll
            for (int m = 0; m < 4; ++m) { const size_t row = (size_t)(row0 + ai * 128 + m * 16);
#pragma unroll
                for (int bj = 0; bj < 2; ++bj) { const int col = col0 + bj * 128;
                    const u32x4 gb = gbw[m][bj];
                    float gbf[8] = {bf_lo(gb.x), bf_hi(gb.x), bf_lo(gb.y), bf_hi(gb.y), bf_lo(gb.z), bf_hi(gb.z), bf_lo(gb.w), bf_hi(gb.w)};
#pragma unroll
                    for (int j = 0; j < 8; ++j) gbf[j] = fmaxf(gbf[j], 1e-6f);
                    if (which == 0) {
                        const u32x4 ga = gaw[m][bj];
                        const float gaf[8] = {bf_lo(ga.x), bf_hi(ga.x), bf_lo(ga.y), bf_hi(ga.y), bf_lo(ga.z), bf_hi(ga.z), bf_lo(ga.w), bf_hi(ga.w)};
#pragma unroll
                        for (int j = 0; j < 4; ++j) { acc[ai][bj][m][0][j] *= gaf[j] * __builtin_amdgcn_rcpf(gbf[j]); acc[ai][bj][m][1][j] *= gaf[4 + j] * __builtin_amdgcn_rcpf(gbf[4 + j]); }
                    } else {
                        f32x4 v0 = acc[ai][bj][m][0], v1 = acc[ai][bj][m][1];
#pragma unroll
                        for (int j = 0; j < 4; ++j) { v0[j] *= gbf[j]; v1[j] *= gbf[4 + j]; }
                        u32x4 w; w.x = cvt_pk_bf16(v0[0], v0[1]); w.y = cvt_pk_bf16(v0[2], v0[3]); w.z = cvt_pk_bf16(v1[0], v1[1]); w.w = cvt_pk_bf16(v1[2], v1[3]);
                        *(u32x4*)(merged + row * 1024 + col) = w; } } }
        }
        return which == 0;
    }
};
struct EpiY1 {
    static constexpr bool PERM = true;
    const float* x; const float* mod; bf16_t* y1;
    __device__ __forceinline__ bool operator()(f32x4 (&acc)[2][2][4][2], const pg8::Unit& u, int wr, int wc, int fr, int fq) const {
        const int row0 = u.pm * 256 + wr * 64 + fr, col0 = u.pn * 256 + wc * 32 + 8 * fq;
        const int b = (u.pm * 256) >> 13;
        f32x4 gt[2][2];
#pragma unroll
        for (int bj = 0; bj < 2; ++bj)
#pragma unroll
            for (int n = 0; n < 2; ++n) gt[bj][n] = *(const f32x4*)(mod + b * 6144 + 2048 + col0 + bj * 128 + n * 4) + 1.0f;
#pragma unroll
        for (int ai = 0; ai < 2; ++ai)
#pragma unroll
            for (int mp = 0; mp < 2; ++mp) {
                f32x4 xv[2][2][2];
#pragma unroll
                for (int mm = 0; mm < 2; ++mm)
#pragma unroll
                    for (int bj = 0; bj < 2; ++bj) { const size_t off = (size_t)(row0 + ai * 128 + (mp * 2 + mm) * 16) * 1024 + col0 + bj * 128;
                        xv[mm][bj][0] = *(const f32x4*)(x + off); xv[mm][bj][1] = *(const f32x4*)(x + off + 4); }
#pragma unroll
                for (int mm = 0; mm < 2; ++mm)
#pragma unroll
                    for (int bj = 0; bj < 2; ++bj) { const int m = mp * 2 + mm; const size_t off = (size_t)(row0 + ai * 128 + m * 16) * 1024 + col0 + bj * 128;
                        const f32x4 v0 = xv[mm][bj][0] * ALPHA + gt[bj][0] * acc[ai][bj][m][0], v1 = xv[mm][bj][1] * ALPHA + gt[bj][1] * acc[ai][bj][m][1];
                        u32x4 w; w.x = cvt_pk_bf16(v0[0], v0[1]); w.y = cvt_pk_bf16(v0[2], v0[3]); w.z = cvt_pk_bf16(v1[0], v1[1]); w.w = cvt_pk_bf16(v1[2], v1[3]);
                        *(u32x4*)(y1 + off) = w; }
            }
        return false;
    }
};
struct EpiQ {
    static constexpr bool PERM = true;
    bf16_t* q;
    __device__ __forceinline__ bool operator()(f32x4 (&acc)[2][2][4][2], const pg8::Unit& u, int wr, int wc, int fr, int fq) const {
        const int row0 = u.pm * 256 + wr * 64 + fr, col0 = u.pn * 256 + wc * 32 + 8 * fq;
#pragma unroll
        for (int ai = 0; ai < 2; ++ai)
#pragma unroll
            for (int m = 0; m < 4; ++m) { bf16_t* rowp = q + (size_t)(row0 + ai * 128 + m * 16) * 2048 + col0;
#pragma unroll
                for (int bj = 0; bj < 2; ++bj) { const f32x4 v0 = acc[ai][bj][m][0], v1 = acc[ai][bj][m][1];
                    u32x4 w; w.x = cvt_pk_bf16(v0[0], v0[1]); w.y = cvt_pk_bf16(v0[2], v0[3]); w.z = cvt_pk_bf16(v1[0], v1[1]); w.w = cvt_pk_bf16(v1[2], v1[3]);
                    *(u32x4*)(rowp + bj * 128) = w; } }
        return false;
    }
};

struct Args { const float* in[22]; float* out; unsigned char* ws; int ph_lo, ph_hi; };

constexpr float PU_SCALE = 48.0f, PV_SCALE = 7.0f;
typedef float f32x32 __attribute__((ext_vector_type(32)));
typedef _Float16 f16x32 __attribute__((ext_vector_type(32)));
typedef unsigned u32x6 __attribute__((ext_vector_type(6)));
typedef u32x4 u32x4_a8 __attribute__((aligned(8)));
__device__ __forceinline__ void cvt32_fp6(const float* src, unsigned char* dst, size_t i, float sc) {
    f16x32 hv;
#pragma unroll
    for (int q = 0; q < 8; ++q) { const f32x4 a = *(const f32x4*)(src + i * 32 + q * 4) * sc;
        hv[q * 4 + 0] = (_Float16)a[0]; hv[q * 4 + 1] = (_Float16)a[1]; hv[q * 4 + 2] = (_Float16)a[2]; hv[q * 4 + 3] = (_Float16)a[3]; }
    const u32x6 r = __builtin_amdgcn_cvt_scalef32_pk32_fp6_f16(hv, 1.0f);
    unsigned char* q = dst + i * 24;
    *(u32x4_a8*)q = (u32x4){r[0], r[1], r[2], r[3]}; *(u32x2*)(q + 16) = (u32x2){r[4], r[5]};
}
__device__ __forceinline__ void cvt8(const float* src, bf16_t* dst, size_t i) {
    const f32x4 a = *(const f32x4*)(src + i * 8), b = *(const f32x4*)(src + i * 8 + 4);
    u32x4 w; w.x = cvt_pk_bf16(a[0], a[1]); w.y = cvt_pk_bf16(a[2], a[3]); w.z = cvt_pk_bf16(b[0], b[1]); w.w = cvt_pk_bf16(b[2], b[3]);
    *(u32x4*)(dst + i * 8) = w;
}
__device__ __forceinline__ void transpose_tile(const float* W, bf16_t* Wt, int K, int N, int k0, int n0, float* tile  ) {
    const int tid = threadIdx.x;
    __syncthreads();
#pragma unroll
    for (int p = 0; p < 2; ++p) { const int kk = (tid >> 4) + p * 32, n4 = tid & 15;
        const f32x4 v = *(const f32x4*)(W + (size_t)(k0 + kk) * N + n0 + n4 * 4);
        tile[kk * 65 + n4 * 4 + 0] = v[0]; tile[kk * 65 + n4 * 4 + 1] = v[1]; tile[kk * 65 + n4 * 4 + 2] = v[2]; tile[kk * 65 + n4 * 4 + 3] = v[3]; }
    __syncthreads();
    const int nn = tid >> 3, k8 = tid & 7;
    float f[8];
#pragma unroll
    for (int j = 0; j < 8; ++j) f[j] = tile[(k8 * 8 + j) * 65 + nn];
    u32x4 w; w.x = cvt_pk_bf16(f[0], f[1]); w.y = cvt_pk_bf16(f[2], f[3]); w.z = cvt_pk_bf16(f[4], f[5]); w.w = cvt_pk_bf16(f[6], f[7]);
    *(u32x4*)(Wt + (size_t)(n0 + nn) * K + k0 + k8 * 8) = w;
}
__device__ __forceinline__ void p_prep(const Args& a, unsigned char* lds) {
    unsigned char* ws = a.ws;
    const int tid = threadIdx.x, G = gridDim.x, bid = blockIdx.x;
    const size_t gtid = (size_t)bid * 512 + tid, gstride = (size_t)G * 512;
    {
        float* sc = (float*)lds;
        float* part = (float*)(lds + 32768);
        const float* c = a.in[1]; const float* w_ada = a.in[2]; const float* b_ada = a.in[3];
        float* mod = (float*)(ws + WS_MOD);
        for (int i = tid; i < 8192; i += 512) { const float v = c[i]; sc[i] = v / (1.0f + __expf(-v)); }
        __syncthreads();
        for (int task = bid; task < 256; task += G) {
            const int cg3 = tid & 7, ks = tid >> 3, n0 = task * 24 + cg3 * 3;
            float acc[8][3];
#pragma unroll
            for (int b = 0; b < 8; ++b) { acc[b][0] = 0.f; acc[b][1] = 0.f; acc[b][2] = 0.f; }
#pragma unroll 4
            for (int kk = 0; kk < 16; ++kk) { const int k = ks * 16 + kk;
                const float w0 = w_ada[(size_t)k * 6144 + n0], w1 = w_ada[(size_t)k * 6144 + n0 + 1], w2 = w_ada[(size_t)k * 6144 + n0 + 2];
#pragma unroll
                for (int b = 0; b < 8; ++b) { const float s = sc[b * 1024 + k]; acc[b][0] += s * w0; acc[b][1] += s * w1; acc[b][2] += s * w2; } }
            __syncthreads();
#pragma unroll
            for (int b = 0; b < 8; ++b)
#pragma unroll
                for (int j = 0; j < 3; ++j) part[(ks * 8 + b) * 24 + cg3 * 3 + j] = acc[b][j];
            __syncthreads();
            if (tid < 192) { const int b = tid / 24, cc = tid % 24; float s = 0.f;
                for (int k2 = 0; k2 < 64; ++k2) s += part[(k2 * 8 + b) * 24 + cc];
                mod[b * 6144 + task * 24 + cc] = s + b_ada[task * 24 + cc]; }
        }
        __syncthreads();
    }
    {
        float* tile = (float*)lds;
        for (int tl = bid; tl < 2624; tl += G) {
            const float* W; bf16_t* Wt; int N, idx;
            if (tl < 1344) { W = a.in[4]; Wt = (bf16_t*)(ws + WS_WIN); N = 5376; idx = tl; }
            else if (tl < 1600) { W = a.in[10]; Wt = (bf16_t*)(ws + WS_WAB); N = 1024; idx = tl - 1344; }
            else if (tl < 1856) { W = a.in[11]; Wt = (bf16_t*)(ws + WS_WAB) + (size_t)1024 * 1024; N = 1024; idx = tl - 1600; }
            else if (tl < 2112) { W = a.in[12]; Wt = (bf16_t*)(ws + WS_WOUT); N = 1024; idx = tl - 1856; }
            else { W = a.in[15]; Wt = (bf16_t*)(ws + WS_WPQ); N = 2048; idx = tl - 2112; }
            const int nN = N / 64, kt = idx / nN, ntile = idx % nN;
            transpose_tile(W, Wt, 1024, N, kt * 64, ntile * 64, tile);
        }
        __syncthreads();
    }
    {
        const float* pu = a.in[18]; const float* pv = a.in[19];
        bf16_t* PU = (bf16_t*)(ws + WS_PU); bf16_t* PV = (bf16_t*)(ws + WS_PV);
        const size_t n32 = (size_t)16384 * 1024 / 32;
        for (size_t i = gtid; i < n32; i += gstride) { cvt32_fp6(pu, (unsigned char*)PU, i, PU_SCALE); cvt32_fp6(pv, (unsigned char*)PV, i, PV_SCALE); }
        bf16_t* SK = (bf16_t*)(ws + WS_SK);
        for (size_t i = gtid; i < 131072 / 8; i += gstride) { cvt8(a.in[16], SK, i); cvt8(a.in[17], SK + 131072, i); }
        bf16_t* WSP = (bf16_t*)(ws + WS_WSP); const float* wsp = a.in[7];
        for (size_t i = gtid; i < 131072 / 8; i += gstride) {
            const int e0 = (int)i * 8, s0 = e0 & 127, t = (e0 >> 7) & 127;
            f32x4 x0 = *(const f32x4*)(wsp + e0), x1 = *(const f32x4*)(wsp + e0 + 4);
#pragma unroll
            for (int j = 0; j < 4; ++j) { if (s0 + j > t) x0[j] = 0.f; if (s0 + 4 + j > t) x1[j] = 0.f; }
            u32x4 w; w.x = cvt_pk_bf16(x0[0], x0[1]); w.y = cvt_pk_bf16(x0[2], x0[3]); w.z = cvt_pk_bf16(x1[0], x1[1]); w.w = cvt_pk_bf16(x1[2], x1[3]);
            *(u32x4*)(WSP + e0) = w;
        }
    }
}

__device__ __forceinline__ void p_h(const Args& a) {
    const float* x = a.in[0]; const float* mod = (const float*)(a.ws + WS_MOD); bf16_t* H = (bf16_t*)(a.ws + WS_AO);
    const size_t gtid = (size_t)blockIdx.x * 512 + threadIdx.x, gstride = (size_t)gridDim.x * 512;
    for (size_t i = gtid; i < (size_t)T * D / 8; i += gstride) {
        const size_t e = i * 8; const int col = (int)(e & 1023), b = (int)(e >> 23);
        const float* mp = mod + b * 6144;
        const f32x4 x0 = *(const f32x4*)(x + e), x1 = *(const f32x4*)(x + e + 4);
        const f32x4 s0 = *(const f32x4*)(mp + 1024 + col), s1 = *(const f32x4*)(mp + 1024 + col + 4);
        const f32x4 h0 = *(const f32x4*)(mp + col), h1 = *(const f32x4*)(mp + col + 4);
        const f32x4 r0 = x0 * (s0 + 1.0f) + h0, r1 = x1 * (s1 + 1.0f) + h1;
        u32x4 w; w.x = cvt_pk_bf16(r0[0], r0[1]); w.y = cvt_pk_bf16(r0[2], r0[3]); w.z = cvt_pk_bf16(r1[0], r1[1]); w.w = cvt_pk_bf16(r1[2], r1[3]);
        *(u32x4*)(H + e) = w;
    }
}

__device__ __forceinline__ void p_gmlp(const Args& a, unsigned char* lds) {
    const bf16_t* ZUV = (const bf16_t*)(a.ws + WS_ZUV); bf16_t* AO = (bf16_t*)(a.ws + WS_AO);
    const bf16_t* WSP = (const bf16_t*)(a.ws + WS_WSP);
    const float* lnv_g = a.in[5]; const float* lnv_b = a.in[6]; const float* b_sp = a.in[8];
    const int tid = threadIdx.x, lane = tid & 63, wid = tid >> 6, g4 = lane >> 4, l15 = lane & 15;
    constexpr int VS = 272;
    unsigned char* VnT = lds;
    float* stats = (float*)(lds + 36864);
    for (int ch = blockIdx.x; ch < 512; ch += gridDim.x) {
        const size_t t0 = (size_t)ch * 128;
        __syncthreads();
#pragma unroll 1
        for (int r8 = 0; r8 < 16; r8 += 8) {
            u32x4 p0[8], p1[8];
#pragma unroll
            for (int r = 0; r < 8; ++r) { const bf16_t* vp = ZUV + (t0 + wid * 16 + r8 + r) * 2048 + 1024; p0[r] = *(const u32x4*)(vp + lane * 8); p1[r] = *(const u32x4*)(vp + 512 + lane * 8); }
#pragma unroll
            for (int r = 0; r < 8; ++r) { const int s = wid * 16 + r8 + r;
                float f[16] = {bf_lo(p0[r].x), bf_hi(p0[r].x), bf_lo(p0[r].y), bf_hi(p0[r].y), bf_lo(p0[r].z), bf_hi(p0[r].z), bf_lo(p0[r].w), bf_hi(p0[r].w),
                               bf_lo(p1[r].x), bf_hi(p1[r].x), bf_lo(p1[r].y), bf_hi(p1[r].y), bf_lo(p1[r].z), bf_hi(p1[r].z), bf_lo(p1[r].w), bf_hi(p1[r].w)};
                float sm = 0.f;
#pragma unroll
                for (int j = 0; j < 16; ++j) sm += f[j];
                const float mu = wave_sum(sm) * (1.0f / 1024.0f);
                float q = 0.f;
#pragma unroll
                for (int j = 0; j < 16; ++j) { const float d = f[j] - mu; q += d * d; }
                const float var = wave_sum(q) * (1.0f / 1024.0f);
                if (lane == 0) { stats[s * 2] = mu; stats[s * 2 + 1] = rsqrtf(var + LN_EPS); }
            }
        }
        __syncthreads();
        for (int g = 0; g < 8; ++g) {
            { const int d8 = tid & 15;
              u32x4 pv[4];
#pragma unroll
              for (int i = 0; i < 4; ++i) pv[i] = *(const u32x4*)(ZUV + (t0 + (tid >> 4) + 32 * i) * 2048 + 1024 + g * 128 + d8 * 8);
              const f32x4 ga = *(const f32x4*)(lnv_g + g * 128 + d8 * 8), gb = *(const f32x4*)(lnv_g + g * 128 + d8 * 8 + 4);
              const f32x4 ba = *(const f32x4*)(lnv_b + g * 128 + d8 * 8), bb = *(const f32x4*)(lnv_b + g * 128 + d8 * 8 + 4);
              const float gg[8] = {ga[0], ga[1], ga[2], ga[3], gb[0], gb[1], gb[2], gb[3]};
              const float bbv[8] = {ba[0], ba[1], ba[2], ba[3], bb[0], bb[1], bb[2], bb[3]};
#pragma unroll
              for (int i = 0; i < 4; ++i) { const int s = (tid >> 4) + 32 * i; const u32x4 p = pv[i];
                const float mu = stats[s * 2], rs = stats[s * 2 + 1];
                float f[8] = {bf_lo(p.x), bf_hi(p.x), bf_lo(p.y), bf_hi(p.y), bf_lo(p.z), bf_hi(p.z), bf_lo(p.w), bf_hi(p.w)};
#pragma unroll
                for (int j = 0; j < 8; j += 2) { const float y0 = (f[j] - mu) * rs * gg[j] + bbv[j], y1 = (f[j + 1] - mu) * rs * gg[j + 1] + bbv[j + 1];
                    const unsigned w = cvt_pk_bf16(y0, y1);
                    *(bf16_t*)(VnT + (d8 * 8 + j) * VS + d8 * 16 + s * 2) = (bf16_t)(w & 0xffffu);
                    *(bf16_t*)(VnT + (d8 * 8 + j + 1) * VS + d8 * 16 + s * 2) = (bf16_t)(w >> 16); }
              } }
            __syncthreads();
            f32x4 acc[8];
#pragma unroll
            for (int db = 0; db < 8; ++db) acc[db] = (f32x4){0.f, 0.f, 0.f, 0.f};
            const int tl = wid * 16 + l15;
            const int nkc = (wid * 16 + 15) / 32 + 1;
            bf16x8 bw[4];
#pragma unroll
            for (int kc = 0; kc < 4; ++kc) bw[kc] = *(const bf16x8*)(WSP + ((size_t)g * 128 + tl) * 128 + (kc < nkc ? kc : 0) * 32 + g4 * 8);
            const float bs = b_sp[g * 128 + tl];
            const bf16_t* up = ZUV + (t0 + tl) * 2048 + g * 128 + g4 * 4;
            u32x2 uw[8];
#pragma unroll
            for (int db = 0; db < 8; ++db) uw[db] = *(const u32x2*)(up + db * 16);
#pragma unroll
            for (int kc = 0; kc < 4; ++kc) {
                if (kc < nkc) {
#pragma unroll
                    for (int db = 0; db < 8; ++db) {
                        const bf16x8 av = *(const bf16x8*)(VnT + (db * 16 + l15) * VS + (db * 2 + (l15 >> 3)) * 16 + (kc * 32 + g4 * 8) * 2);
                        acc[db] = __builtin_amdgcn_mfma_f32_16x16x32_bf16(av, bw[kc], acc[db], 0, 0, 0);
                    }
                }
            }
            bf16_t* ap = AO + (t0 + tl) * 1024 + g * 128 + g4 * 4;
#pragma unroll
            for (int db = 0; db < 8; ++db) {
                const float r0 = bf_lo(uw[db].x) * (acc[db][0] + bs), r1 = bf_hi(uw[db].x) * (acc[db][1] + bs), r2 = bf_lo(uw[db].y) * (acc[db][2] + bs), r3 = bf_hi(uw[db].y) * (acc[db][3] + bs);
                u32x2 ow; ow.x = cvt_pk_bf16(r0, r1); ow.y = cvt_pk_bf16(r2, r3);
                *(u32x2*)(ap + db * 16) = ow;
            }
            __syncthreads();
        }
    }
}

__device__ __forceinline__ void p_attn(const Args& a, unsigned char* lds) {
    const bf16_t* QKV = (const bf16_t*)(a.ws + WS_QKV); bf16_t* O = (bf16_t*)(a.ws + WS_AO) + (size_t)T * 1024;
    const float* sinks = a.in[9];
    const int tid = threadIdx.x, lane = tid & 63, wid = tid >> 6, g4 = lane >> 4, l15 = lane & 15;
    constexpr int KS = 144, VTS = 528;
    unsigned char* Ks = lds;
    unsigned char* Vt = lds + 36864;
    for (int tl = blockIdx.x; tl < 1024; tl += gridDim.x) {
        const int kvh = tl & 1, n = (tl >> 1) & 63, b = tl >> 7;
        const long tq0 = (long)b * SEQ + (long)n * 128;
        const long tk0 = tq0 - 128;
        __syncthreads();
#pragma unroll
        for (int i = 0; i < 4; ++i) { const int idx = tid + 512 * i, j = idx >> 3, c8 = idx & 7;
            u32x4 kw = (u32x4){0u, 0u, 0u, 0u}, vw = (u32x4){0u, 0u, 0u, 0u};
            if (n > 0 || j >= 128) { const bf16_t* rp = QKV + (size_t)(tk0 + j) * 1280;
                kw = *(const u32x4*)(rp + 1024 + kvh * 64 + c8 * 8); vw = *(const u32x4*)(rp + 1152 + kvh * 64 + c8 * 8); }
            *(u32x4*)(Ks + j * KS + c8 * 16) = kw;
            const unsigned vv[4] = {vw.x, vw.y, vw.z, vw.w};
#pragma unroll
            for (int e = 0; e < 4; ++e) { *(bf16_t*)(Vt + (c8 * 8 + 2 * e) * VTS + c8 * 16 + j * 2) = (bf16_t)(vv[e] & 0xffffu); *(bf16_t*)(Vt + (c8 * 8 + 2 * e + 1) * VTS + c8 * 16 + j * 2) = (bf16_t)(vv[e] >> 16); }
        }
        __syncthreads();
        const int hq = kvh * 8 + wid;
        const float sink = sinks[hq];
        bf16x8 nq0, nq1;
        { const bf16_t* qp = QKV + (size_t)(tq0 + l15) * 1280 + hq * 64 + g4 * 8; nq0 = *(const bf16x8*)qp; nq1 = *(const bf16x8*)(qp + 32); }
#pragma unroll 1
        for (int rb = 0; rb < 8; ++rb) {
            const long tq = tq0 + rb * 16 + l15;
            const bf16x8 q0 = nq0, q1 = nq1;
            if (rb < 7) { const bf16_t* qp = QKV + (size_t)(tq + 16) * 1280 + hq * 64 + g4 * 8; nq0 = *(const bf16x8*)qp; nq1 = *(const bf16x8*)(qp + 32); }
            const int kb0 = rb & ~1;
            f32x4 s[10];
#pragma unroll
            for (int kbi = 0; kbi < 10; ++kbi) { const int kb = kb0 + kbi;
                const bf16x8 k0 = *(const bf16x8*)(Ks + (kb * 16 + l15) * KS + g4 * 16), k1 = *(const bf16x8*)(Ks + (kb * 16 + l15) * KS + 64 + g4 * 16);
                f32x4 c = (f32x4){0.f, 0.f, 0.f, 0.f};
                c = __builtin_amdgcn_mfma_f32_16x16x32_bf16(k0, q0, c, 0, 0, 0);
                c = __builtin_amdgcn_mfma_f32_16x16x32_bf16(k1, q1, c, 0, 0, 0);
                s[kbi] = c; }
            const int qi = rb * 16 + l15 + 128;
            float mx = sink;
#pragma unroll
            for (int kbi = 0; kbi < 10; ++kbi)
#pragma unroll
                for (int r = 0; r < 4; ++r) { const int ki = (kb0 + kbi) * 16 + g4 * 4 + r;
                    const bool valid = (ki <= qi) && (ki > qi - 128) && (n > 0 || ki >= 128);
                    const float v = valid ? s[kbi][r] * 0.125f : -1e30f; s[kbi][r] = v; mx = fmaxf(mx, v); }
            mx = fmaxf(mx, __shfl_xor(mx, 16)); mx = fmaxf(mx, __shfl_xor(mx, 32));
            float l = 0.f;
#pragma unroll
            for (int kbi = 0; kbi < 10; ++kbi)
#pragma unroll
                for (int r = 0; r < 4; ++r) { const float p = __expf(s[kbi][r] - mx); s[kbi][r] = p; l += p; }
            l += __shfl_xor(l, 16); l += __shfl_xor(l, 32);
            l += __expf(sink - mx);
            const float inv = 1.0f / l;
            f32x4 o[4];
#pragma unroll
            for (int db = 0; db < 4; ++db) o[db] = (f32x4){0.f, 0.f, 0.f, 0.f};
#pragma unroll
            for (int c = 0; c < 5; ++c) {
                u32x4 pw; pw.x = cvt_pk_bf16(s[2 * c][0], s[2 * c][1]); pw.y = cvt_pk_bf16(s[2 * c][2], s[2 * c][3]);
                pw.z = cvt_pk_bf16(s[2 * c + 1][0], s[2 * c + 1][1]); pw.w = cvt_pk_bf16(s[2 * c + 1][2], s[2 * c + 1][3]);
                const bf16x8 pb = __builtin_bit_cast(bf16x8, pw);
                const int key0 = (kb0 + 2 * c) * 16 + g4 * 4;
#pragma unroll
                for (int db = 0; db < 4; ++db) {
                    const u32x2 va = *(const u32x2*)(Vt + (db * 16 + l15) * VTS + (db * 2 + (l15 >> 3)) * 16 + key0 * 2), vb = *(const u32x2*)(Vt + (db * 16 + l15) * VTS + (db * 2 + (l15 >> 3)) * 16 + (key0 + 16) * 2);
                    u32x4 vw; vw.x = va.x; vw.y = va.y; vw.z = vb.x; vw.w = vb.y;
                    o[db] = __builtin_amdgcn_mfma_f32_16x16x32_bf16(__builtin_bit_cast(bf16x8, vw), pb, o[db], 0, 0, 0);
                }
            }
            bf16_t* op = O + (size_t)tq * 1024 + hq * 64 + g4 * 4;
#pragma unroll
            for (int db = 0; db < 4; ++db) { u32x2 ow; ow.x = cvt_pk_bf16(o[db][0] * inv, o[db][1] * inv); ow.y = cvt_pk_bf16(o[db][2] * inv, o[db][3] * inv);
                *(u32x2*)(op + db * 16) = ow; }
        }
    }
}

__device__ __forceinline__ void p_ln1(const Args& a) {
    const bf16_t* Y1 = (const bf16_t*)(a.ws + WS_ZUV); const float* mod = (const float*)(a.ws + WS_MOD);
    float* stats = (float*)(a.ws + WS_STATS); bf16_t* H2 = (bf16_t*)(a.ws + WS_QKV);
    const float* g1 = a.in[13]; const float* b1 = a.in[14];
    const int lane = threadIdx.x & 63; const int gw = blockIdx.x * 8 + (threadIdx.x >> 6), nw = gridDim.x * 8;
    float gg[16], bb[16];
#pragma unroll
    for (int h = 0; h < 2; ++h)
#pragma unroll
        for (int j = 0; j < 8; ++j) { gg[h * 8 + j] = g1[h * 512 + lane * 8 + j]; bb[h * 8 + j] = b1[h * 512 + lane * 8 + j]; }
    int t = gw; if (t >= T) return;
    u32x4 n0 = *(const u32x4*)(Y1 + (size_t)t * 1024 + lane * 8), n1 = *(const u32x4*)(Y1 + (size_t)t * 1024 + 512 + lane * 8);
    for (; t < T; t += nw) {
        const u32x4 p0 = n0, p1 = n1;
        const int tn = t + nw < T ? t + nw : t;
        n0 = *(const u32x4*)(Y1 + (size_t)tn * 1024 + lane * 8); n1 = *(const u32x4*)(Y1 + (size_t)tn * 1024 + 512 + lane * 8);
        const int b = t >> 13; const float* mp = mod + b * 6144;
        float v[16] = {bf_lo(p0.x), bf_hi(p0.x), bf_lo(p0.y), bf_hi(p0.y), bf_lo(p0.z), bf_hi(p0.z), bf_lo(p0.w), bf_hi(p0.w),
                       bf_lo(p1.x), bf_hi(p1.x), bf_lo(p1.y), bf_hi(p1.y), bf_lo(p1.z), bf_hi(p1.z), bf_lo(p1.w), bf_hi(p1.w)};
        float sm = 0.f;
#pragma unroll
        for (int j = 0; j < 16; ++j) sm += v[j];
        const float mu = wave_sum(sm) * (1.0f / 1024.0f);
        float q = 0.f;
#pragma unroll
        for (int j = 0; j < 16; ++j) { const float d = v[j] - mu; q += d * d; }
        const float rs = rsqrtf(wave_sum(q) * (1.0f / 1024.0f) + LN_EPS);
        if (lane == 0) { stats[t * 2] = mu; stats[t * 2 + 1] = rs; }
#pragma unroll
        for (int h = 0; h < 2; ++h) { const int col = h * 512 + lane * 8; float r[8];
            const f32x4 sc0 = *(const f32x4*)(mp + 4096 + col), sc1 = *(const f32x4*)(mp + 4096 + col + 4), sh0 = *(const f32x4*)(mp + 3072 + col), sh1 = *(const f32x4*)(mp + 3072 + col + 4);
#pragma unroll
            for (int j = 0; j < 8; ++j) { const float x1v = (v[h * 8 + j] - mu) * rs * gg[h * 8 + j] + bb[h * 8 + j]; r[j] = x1v * (1.0f + (j < 4 ? sc0[j] : sc1[j - 4])) + (j < 4 ? sh0[j] : sh1[j - 4]); }
            u32x4 w; w.x = cvt_pk_bf16(r[0], r[1]); w.y = cvt_pk_bf16(r[2], r[3]); w.z = cvt_pk_bf16(r[4], r[5]); w.w = cvt_pk_bf16(r[6], r[7]);
            *(u32x4*)(H2 + (size_t)t * 1024 + col) = w; }
    }
}

__device__ __forceinline__ unsigned ordf(float f) { const unsigned b = __float_as_uint(f); return b ^ ((unsigned)((int)b >> 31) | 0x80000000u); }
__device__ __forceinline__ float unordf(unsigned u) { const unsigned b = (u & 0x80000000u) ? (u ^ 0x80000000u) : ~u; return __uint_as_float(b); }
__device__ __forceinline__ void bitonic_sort16(unsigned (&k)[16]) {
#pragma unroll
    for (int size = 2; size <= 16; size <<= 1) {
#pragma unroll
        for (int stride = size >> 1; stride >= 1; stride >>= 1) {
#pragma unroll
            for (int i = 0; i < 16; ++i) { const int l = i ^ stride;
                if (l > i) { const bool desc = ((i & size) == 0); const unsigned hi = max(k[i], k[l]), lo = min(k[i], k[l]); k[i] = desc ? hi : lo; k[l] = desc ? lo : hi; } }
        }
    }
}
__device__ __forceinline__ void bitonic_merge16(unsigned (&k)[16]) {
#pragma unroll
    for (int stride = 8; stride >= 1; stride >>= 1) {
#pragma unroll
        for (int i = 0; i < 16; ++i) { const int l = i ^ stride;
            if (l > i) { const unsigned hi = max(k[i], k[l]), lo = min(k[i], k[l]); k[i] = hi; k[l] = lo; } }
    }
}
__device__ __forceinline__ void merge_across4(unsigned (&c)[16]) {
#pragma unroll
    for (int lv = 16; lv <= 32; lv <<= 1) {
        unsigned p[16];
#pragma unroll
        for (int i = 0; i < 16; ++i) p[i] = (unsigned)__shfl_xor((int)c[15 - i], lv);
#pragma unroll
        for (int i = 0; i < 16; ++i) c[i] = max(c[i], p[i]);
        bitonic_merge16(c);
    }
}
__device__ __forceinline__ void peer_half_scores(const unsigned char* SKl  , const bf16x8 (&qf)[4], int l15, int g4, unsigned (&sel)[16]) {
    unsigned ka[16], kb2[16];
#pragma unroll
    for (int kb = 0; kb < 8; ++kb) { f32x4 c = (f32x4){0.f, 0.f, 0.f, 0.f};
#pragma unroll
        for (int ks = 0; ks < 4; ++ks) { const bf16x8 kf = *(const bf16x8*)(SKl + (kb * 16 + l15) * 272 + ks * 64 + g4 * 16);
            c = __builtin_amdgcn_mfma_f32_16x16x32_bf16(kf, qf[ks], c, 0, 0, 0); }
#pragma unroll
        for (int r = 0; r < 4; ++r) { const unsigned kk = (ordf(c[r]) & ~127u) | (unsigned)(kb * 16 + g4 * 4 + r);
            if (kb < 4) ka[kb * 4 + r] = kk; else kb2[(kb - 4) * 4 + r] = kk; }
        if (kb & 1) __builtin_amdgcn_sched_barrier(0); }
    bitonic_sort16(ka); bitonic_sort16(kb2);
#pragma unroll
    for (int i = 0; i < 16; ++i) sel[i] = max(ka[i], kb2[15 - i]);
    bitonic_merge16(sel);
    merge_across4(sel);
}
__host__ __device__ constexpr int cand_i(int g, int s) { return g == 0 ? 0 : g == 1 ? (s < 8 ? 1 : s < 13 ? 2 : 3) : g == 2 ? (s == 0 ? 3 : s < 4 ? 4 : s < 6 ? 5 : s < 8 ? 6 : s < 10 ? 7 : s - 2) : (s == 0 ? 14 : 15); }
__host__ __device__ constexpr int cand_j(int g, int s) { return g == 0 ? s : g == 1 ? (s < 8 ? s : s < 13 ? s - 8 : s - 13) : g == 2 ? (s == 0 ? 3 : s < 4 ? s - 1 : s < 6 ? s - 4 : s < 8 ? s - 6 : s < 10 ? s - 8 : 0) : 0; }

__device__ __forceinline__ void p_topk(const Args& a, unsigned char* lds) {
    const bf16_t* Q = (const bf16_t*)(a.ws + WS_GATES); const bf16_t* SK = (const bf16_t*)(a.ws + WS_SK);
    int* IDX = (int*)(a.ws + WS_IDX); float* WGT = (float*)(a.ws + WS_WGT);
    const int tid = threadIdx.x, lane = tid & 63, wid = tid >> 6, g4 = lane >> 4, l15 = lane & 15;
    for (int unit = blockIdx.x; unit < 256; unit += gridDim.x) {
        const int h = unit & 7, c = unit >> 3;
        __syncthreads();
#pragma unroll
        for (int i = 0; i < 8; ++i) { const int idx = tid + 512 * i, half = idx >> 11, row = (idx >> 4) & 127, pc = idx & 15;
            const u32x4 v = *(const u32x4*)(SK + (size_t)half * 131072 + (size_t)h * 16384 + row * 128 + pc * 8);
            *(u32x4*)(lds + half * 34816 + row * 272 + pc * 16) = v; }
        __syncthreads();
      for (int it = 0; it < 16; ++it) {
        const int tb = c * 128 + it * 8 + wid;
        const size_t t = (size_t)tb * 16 + l15;
        bf16x8 q1[4], q2[4];
        { const bf16_t* qp = Q + t * 2048 + h * 256 + g4 * 8;
#pragma unroll
          for (int ks = 0; ks < 4; ++ks) { q1[ks] = *(const bf16x8*)(qp + ks * 32); q2[ks] = *(const bf16x8*)(qp + 128 + ks * 32); } }
        unsigned sel1[16], sel2[16];
        peer_half_scores(lds, q1, l15, g4, sel1);
        peer_half_scores(lds + 34816, q2, l15, g4, sel2);
        unsigned ck[16];
#pragma unroll
        for (int s = 0; s < 16; ++s) {
            const unsigned s1 = g4 == 0 ? sel1[cand_i(0, s)] : g4 == 1 ? sel1[cand_i(1, s)] : g4 == 2 ? sel1[cand_i(2, s)] : sel1[cand_i(3, s)];
            const unsigned s2 = g4 == 0 ? sel2[cand_j(0, s)] : g4 == 1 ? sel2[cand_j(1, s)] : g4 == 2 ? sel2[cand_j(2, s)] : sel2[cand_j(3, s)];
            const float sm = unordf(s1 & ~127u) + unordf(s2 & ~127u);
            const unsigned kk = (ordf(sm) & 0xFFFFC000u) | ((s1 & 127u) << 7) | (s2 & 127u);
            ck[s] = (g4 < 3 || s < 2) ? kk : 0u;
        }
        bitonic_sort16(ck);
        merge_across4(ck);
        float wsc[16];
        const float mx0 = unordf(ck[0] & 0xFFFFC000u); float sum = 0.f;
#pragma unroll
        for (int rd = 0; rd < 16; ++rd) { wsc[rd] = __expf(unordf(ck[rd] & 0xFFFFC000u) - mx0); sum += wsc[rd]; }
        const float inv = 1.0f / sum;
        if (g4 == 0) {
            int* ip = IDX + t * 128 + h * 16; float* wp = WGT + t * 128 + h * 16;
#pragma unroll
            for (int q4 = 0; q4 < 4; ++q4) {
                *(u32x4*)(ip + q4 * 4) = (u32x4){ck[q4 * 4] & 0x3FFFu, ck[q4 * 4 + 1] & 0x3FFFu, ck[q4 * 4 + 2] & 0x3FFFu, ck[q4 * 4 + 3] & 0x3FFFu};
                *(f32x4*)(wp + q4 * 4) = (f32x4){wsc[q4 * 4] * inv, wsc[q4 * 4 + 1] * inv, wsc[q4 * 4 + 2] * inv, wsc[q4 * 4 + 3] * inv};
            }
        }
      }
    }
}

template <int CTRL> __device__ __forceinline__ float dpp_f(float v) { return __builtin_bit_cast(float, __builtin_amdgcn_update_dpp(0, __builtin_bit_cast(int, v), CTRL, 0xF, 0xF, true)); }
__device__ __forceinline__ f32x32 fp6x32(const u32x4 a, const u32x2 b) { const u32x6 v = {a.x, a.y, a.z, a.w, b.x, b.y}; return __builtin_amdgcn_cvt_scalef32_pk32_f32_fp6(v, 1.0f); }
__device__ __forceinline__ void p_gdot(const Args& a) {
    const unsigned char* ws = a.ws;
    const bf16_t* H2 = (const bf16_t*)(ws + WS_QKV); const int* IDX = (const int*)(ws + WS_IDX); float* WGT = (float*)(ws + WS_WGT);
    const unsigned char* PU = ws + WS_PU;
    const int lane = threadIdx.x & 63, l31 = lane & 31; const int gw = blockIdx.x * 8 + (threadIdx.x >> 6), nw = gridDim.x * 8;
    const bool up32 = (lane & 32) != 0, up16 = (lane & 16) != 0, up8 = (lane & 8) != 0;
    const int ebi = 2 * (2 * (up16 ? 1 : 0) + (up8 ? 1 : 0)) + (up32 ? 1 : 0);
    int t = gw;
    int ev0 = 0, ev1 = 0; float wv0 = 0.f, wv1 = 0.f;
    if (t < T) { ev0 = IDX[(size_t)t * 128 + lane]; ev1 = IDX[(size_t)t * 128 + 64 + lane]; wv0 = WGT[(size_t)t * 128 + lane]; wv1 = WGT[(size_t)t * 128 + 64 + lane]; }
#define U_LOADX(U4, U2, E0, E1, kbase) do { const int _evs = (kbase) < 64 ? E0 : E1; _Pragma("unroll") for (int s = 0; s < 4; ++s) { \
        const int e0 = __builtin_amdgcn_readlane(_evs, ((kbase) & 63) + 2 * s), e1 = __builtin_amdgcn_readlane(_evs, ((kbase) & 63) + 2 * s + 1); const int e = up32 ? e1 : e0; \
        const unsigned char* up = PU + (size_t)e * 768 + l31 * 24; U4[s] = *(const u32x4_a8*)up; U2[s] = *(const u32x2*)(up + 16); } } while (0)
#define U_COMP(U4, U2, kbase) do { float d[4]; \
        _Pragma("unroll") for (int s = 0; s < 4; ++s) { const f32x32 uf = fp6x32(U4[s], U2[s]); f32x2 sacc = (f32x2){uf[0], uf[1]} * hf[0]; \
            _Pragma("unroll") for (int i = 1; i < 16; ++i) sacc += (f32x2){uf[2 * i], uf[2 * i + 1]} * hf[i]; d[s] = sacc.x + sacc.y; } \
        float k2[2]; _Pragma("unroll") for (int j = 0; j < 2; ++j) { const float snd = up16 ? d[j] : d[j + 2], keep = up16 ? d[j + 2] : d[j]; k2[j] = keep + __shfl_xor(snd, 16); } \
        float r = (up8 ? k2[1] : k2[0]) + dpp_f<0x140>(up8 ? k2[0] : k2[1]); \
        r += dpp_f<0x141>(r); r += dpp_f<0x4E>(r); r += dpp_f<0xB1>(r); \
        const float wsel = __shfl((kbase) < 64 ? wv0 : wv1, ((kbase) & 63) + ebi); \
        const float x = r * (1.0f / PU_SCALE); const float cv = 0.5f * x * (1.0f + erff(x * 0.70710678118f)) * wsel * (1.0f / PV_SCALE); \
        if ((lane & 7) == 0) cp[(kbase) + ebi] = cv; } while (0)
    u32x4 UA4[4], UB4[4]; u32x2 UA2[4], UB2[4]; u32x4 hr[4];
#pragma unroll
    for (int q = 0; q < 4; ++q) hr[q] = (u32x4){0u, 0u, 0u, 0u};
    if (t < T) { U_LOADX(UA4, UA2, ev0, ev1, 0);
#pragma unroll
        for (int q = 0; q < 4; ++q) hr[q] = *(const u32x4*)(H2 + (size_t)t * 1024 + l31 * 32 + q * 8); }
    for (; t < T; t += nw) {
        f32x2 hf[16];
#pragma unroll
        for (int q = 0; q < 4; ++q) { hf[q * 4 + 0] = (f32x2){bf_lo(hr[q].x), bf_hi(hr[q].x)}; hf[q * 4 + 1] = (f32x2){bf_lo(hr[q].y), bf_hi(hr[q].y)};
            hf[q * 4 + 2] = (f32x2){bf_lo(hr[q].z), bf_hi(hr[q].z)}; hf[q * 4 + 3] = (f32x2){bf_lo(hr[q].w), bf_hi(hr[q].w)}; }
        const int tn = t + nw < T ? t + nw : t;
        const int nev0 = IDX[(size_t)tn * 128 + lane], nev1 = IDX[(size_t)tn * 128 + 64 + lane]; const float nwv0 = WGT[(size_t)tn * 128 + lane], nwv1 = WGT[(size_t)tn * 128 + 64 + lane];
#pragma unroll
        for (int q = 0; q < 4; ++q) hr[q] = *(const u32x4*)(H2 + (size_t)tn * 1024 + l31 * 32 + q * 8);
        float* cp = WGT + (size_t)t * 128;
#pragma unroll 1
        for (int b2 = 0; b2 < 8; ++b2) {
            U_LOADX(UB4, UB2, ev0, ev1, 16 * b2 + 8);
            U_COMP(UA4, UA2, 16 * b2);
            if (b2 < 7) U_LOADX(UA4, UA2, ev0, ev1, 16 * b2 + 16); else U_LOADX(UA4, UA2, nev0, nev1, 0);
            U_COMP(UB4, UB2, 16 * b2 + 8);
        }
        ev0 = nev0; ev1 = nev1; wv0 = nwv0; wv1 = nwv1;
    }
#undef U_LOADX
#undef U_COMP
}

__device__ __forceinline__ void p_gather(const Args& a) {
    const unsigned char* ws = a.ws;
    const bf16_t* Y1 = (const bf16_t*)(ws + WS_ZUV); const float* stats = (const float*)(ws + WS_STATS); const float* mod = (const float*)(ws + WS_MOD);
    const int* IDX = (const int*)(ws + WS_IDX); const float* WGT = (const float*)(ws + WS_WGT);
    const unsigned char* PV = ws + WS_PV;
    const float* g1 = a.in[13]; const float* b1 = a.in[14]; const float* g2 = a.in[20]; const float* b2 = a.in[21];
    const int lane = threadIdx.x & 63, l31 = lane & 31; const int gw = blockIdx.x * 8 + (threadIdx.x >> 6), nw = gridDim.x * 8;
    const bool up32 = (lane & 32) != 0;
    int t = gw;
    int ev0 = 0, ev1 = 0; float wv0 = 0.f, wv1 = 0.f;
    if (t < T) { ev0 = IDX[(size_t)t * 128 + lane]; ev1 = IDX[(size_t)t * 128 + 64 + lane]; wv0 = WGT[(size_t)t * 128 + lane]; wv1 = WGT[(size_t)t * 128 + 64 + lane]; }
#define V_LOADX(V4, V2, E0, E1, kbase) do { const int _evs = (kbase) < 64 ? E0 : E1; _Pragma("unroll") for (int s = 0; s < 4; ++s) { \
        const int e0 = __builtin_amdgcn_readlane(_evs, ((kbase) & 63) + 2 * s), e1 = __builtin_amdgcn_readlane(_evs, ((kbase) & 63) + 2 * s + 1); const int e = up32 ? e1 : e0; \
        const unsigned char* vp = PV + (size_t)e * 768 + l31 * 24; V4[s] = *(const u32x4_a8*)vp; V2[s] = *(const u32x2*)(vp + 16); } } while (0)
#define V_COMP(V4, V2, kbase) do { const int _wvs = __builtin_bit_cast(int, (kbase) < 64 ? wv0 : wv1); _Pragma("unroll") for (int s = 0; s < 4; ++s) { \
        const float c0 = __builtin_bit_cast(float, __builtin_amdgcn_readlane(_wvs, ((kbase) & 63) + 2 * s)), c1 = __builtin_bit_cast(float, __builtin_amdgcn_readlane(_wvs, ((kbase) & 63) + 2 * s + 1)); \
        const float cj = up32 ? c1 : c0; const f32x2 cc = (f32x2){cj, cj}; const f32x32 vf = fp6x32(V4[s], V2[s]); \
        _Pragma("unroll") for (int i = 0; i < 16; ++i) acc[i] += cc * (f32x2){vf[2 * i], vf[2 * i + 1]}; } } while (0)
    u32x4 VA4[4], VB4[4]; u32x2 VA2[4], VB2[4];
    if (t < T) V_LOADX(VA4, VA2, ev0, ev1, 0);
    for (; t < T; t += nw) {
        f32x2 acc[16];
#pragma unroll
        for (int j = 0; j < 16; ++j) acc[j] = (f32x2){0.f, 0.f};
        const int tn = t + nw < T ? t + nw : t;
        const int nev0 = IDX[(size_t)tn * 128 + lane], nev1 = IDX[(size_t)tn * 128 + 64 + lane]; const float nwv0 = WGT[(size_t)tn * 128 + lane], nwv1 = WGT[(size_t)tn * 128 + 64 + lane];
        const int colp = l31 * 32 + (up32 ? 16 : 0);
        u32x2 ywp[4];
#pragma unroll
        for (int q4 = 0; q4 < 4; ++q4) ywp[q4] = *(const u32x2*)(Y1 + (size_t)t * 1024 + colp + q4 * 4);
        const float mu1 = stats[t * 2], rs1 = stats[t * 2 + 1];
#pragma unroll 1
        for (int b2 = 0; b2 < 8; ++b2) {
            V_LOADX(VB4, VB2, ev0, ev1, 16 * b2 + 8);
            V_COMP(VA4, VA2, 16 * b2);
            if (b2 < 7) V_LOADX(VA4, VA2, ev0, ev1, 16 * b2 + 16); else V_LOADX(VA4, VA2, nev0, nev1, 0);
            V_COMP(VB4, VB2, 16 * b2 + 8);
        }
        float f[16];
#pragma unroll
        for (int j = 0; j < 8; ++j) {
            const float s0 = up32 ? acc[j].x : acc[8 + j].x, s1 = up32 ? acc[j].y : acc[8 + j].y;
            const float r0 = __shfl_xor(s0, 32), r1 = __shfl_xor(s1, 32);
            f[2 * j] = (up32 ? acc[8 + j].x : acc[j].x) + r0; f[2 * j + 1] = (up32 ? acc[8 + j].y : acc[j].y) + r1; }
        const int b = t >> 13; const float* mp = mod + b * 6144 + 5120;
        const int col = colp;
        float y[16];
#pragma unroll
        for (int q4 = 0; q4 < 4; ++q4) { const u32x2 yw = ywp[q4]; const f32x4 yv = (f32x4){bf_lo(yw.x), bf_hi(yw.x), bf_lo(yw.y), bf_hi(yw.y)};
            const f32x4 gg = *(const f32x4*)(g1 + col + q4 * 4), bb = *(const f32x4*)(b1 + col + q4 * 4), gt = *(const f32x4*)(mp + col + q4 * 4);
#pragma unroll
            for (int j = 0; j < 4; ++j) { const float x1v = (yv[j] - mu1) * rs1 * gg[j] + bb[j]; y[q4 * 4 + j] = ALPHA * x1v + (1.0f + gt[j]) * f[q4 * 4 + j]; } }
        float sm = 0.f;
#pragma unroll
        for (int j = 0; j < 16; ++j) sm += y[j];
        const float mu = wave_sum(sm) * (1.0f / 1024.0f);
        float q = 0.f;
#pragma unroll
        for (int j = 0; j < 16; ++j) { const float dd = y[j] - mu; q += dd * dd; }
        const float rs = rsqrtf(wave_sum(q) * (1.0f / 1024.0f) + LN_EPS);
#pragma unroll
        for (int q4 = 0; q4 < 4; ++q4) { const f32x4 gg = *(const f32x4*)(g2 + col + q4 * 4), bb = *(const f32x4*)(b2 + col + q4 * 4); f32x4 o;
#pragma unroll
            for (int j = 0; j < 4; ++j) o[j] = (y[q4 * 4 + j] - mu) * rs * gg[j] + bb[j];
            *(f32x4*)(a.out + (size_t)t * 1024 + col + q4 * 4) = o; }
        ev0 = nev0; ev1 = nev1; wv0 = nwv0; wv1 = nwv1;
    }
#undef V_LOADX
#undef V_COMP
}

#define XB_TMO      128
#define XB_XCNT(j)  (256  + 64 * (j))
#define XB_XSUB(j)  (1280 + 64 * (j))
#define XB_XGEN(j)  (2304 + 64 * (j))
#define XB_TOP      3328
#define XB_TOPGEN   3392
#define XCD_BAR_WORDS 3456
#define XB_SPIN_CAP (1u << 18)
__device__ __forceinline__ unsigned xb_ld(unsigned* p)              { return __hip_atomic_load(p, __ATOMIC_RELAXED, __HIP_MEMORY_SCOPE_AGENT); }
__device__ __forceinline__ unsigned xb_add(unsigned* p, unsigned v) { return __hip_atomic_fetch_add(p, v, __ATOMIC_RELAXED, __HIP_MEMORY_SCOPE_AGENT); }
__device__ __forceinline__ unsigned xb_xcc_id() { return (unsigned)__builtin_amdgcn_s_getreg((3 << 11) | 20) & 0xFu; }
#define XB_SPIN(cond, bar) do { unsigned _sp = 0; while (cond) { __builtin_amdgcn_s_sleep(1); \
    if ((++_sp & 255u) == 0u) { if (xb_ld(&(bar)[XB_TMO])) break; if (_sp > XB_SPIN_CAP) { atomicAdd(&(bar)[XB_TMO], 1u); break; } } } } while (0)
struct XcdBarrier { unsigned* bar; unsigned x; volatile LAS unsigned* st; };
__device__ __forceinline__ XcdBarrier xcd_barrier_post(unsigned* bar, volatile LAS unsigned* st) {
    XcdBarrier b; b.bar = bar; b.x = xb_xcc_id(); b.st = st;
    if (threadIdx.x == 0) (void)xb_add(&bar[XB_XCNT(b.x)], 1u);
    return b;
}
__device__ __forceinline__ void xcd_barrier_complete(unsigned* bar, unsigned x, unsigned& nloc, unsigned& nx) {
    const unsigned G = gridDim.x * gridDim.y * gridDim.z;
    unsigned sum, cnt, mine, sp = 0u;
    for (;;) {
        sum = 0u; cnt = 0u; mine = 0u;
#pragma unroll
        for (unsigned j = 0; j < 16; ++j) { const unsigned c = xb_ld(&bar[XB_XCNT(j)]); sum += c; cnt += (c > 0u) ? 1u : 0u; mine = (j == x) ? c : mine; }
        if (sum == G) break;
        __builtin_amdgcn_s_sleep(1);
        if ((++sp & 255u) == 0u) { if (xb_ld(&bar[XB_TMO])) break; if (sp > XB_SPIN_CAP) { atomicAdd(&bar[XB_TMO], 1u); break; } }
    }
    nloc = mine > 0u ? mine : 1u; nx = cnt > 0u ? cnt : 1u;
}
__device__ __forceinline__ void xcd_barrier(const XcdBarrier& b) {
    asm volatile("s_waitcnt vmcnt(0)" ::: "memory");
    __syncthreads();
    if (threadIdx.x == 0) {
        unsigned* bar = b.bar;
        __builtin_amdgcn_s_waitcnt(0);
        unsigned nloc = b.st[0], nx = b.st[1];
        if (nloc == 0u) { xcd_barrier_complete(bar, b.x, nloc, nx); b.st[0] = nloc; b.st[1] = nx; }
        const unsigned old = xb_add(&bar[XB_XSUB(b.x)], 1u);
        const unsigned gen = old / nloc;
        if (old + 1u == (gen + 1u) * nloc) {
            __builtin_amdgcn_fence(__ATOMIC_RELEASE, "agent");
            asm volatile("s_waitcnt vmcnt(0)" ::: "memory");
            const unsigned og = xb_add(&bar[XB_TOP], 1u);
            const unsigned tg = og / nx;
            if (og + 1u == (tg + 1u) * nx) xb_add(&bar[XB_TOPGEN], 1u);
            else XB_SPIN(xb_ld(&bar[XB_TOPGEN]) == tg, bar);
            __builtin_amdgcn_fence(__ATOMIC_ACQUIRE, "agent");
            xb_add(&bar[XB_XGEN(b.x)], 1u);
            asm volatile("s_waitcnt vmcnt(0)" ::: "memory");
        } else {
            XB_SPIN(xb_ld(&bar[XB_XGEN(b.x)]) == gen, bar);
            __builtin_amdgcn_fence(__ATOMIC_ACQUIRE, "agent");
            asm volatile("s_waitcnt vmcnt(0)" ::: "memory");
        }
    }
    __syncthreads();
}

constexpr int NPHASE = 11;
constexpr int LDS_BYTES = 128 * 1024 + 1024;

#ifndef REPEAT_MASK
#define REPEAT_MASK 0
#endif
__global__ void __launch_bounds__(512) mega(Args a) {
    extern __shared__ __attribute__((aligned(16))) unsigned char lds[];
    cg::grid_group grid = cg::this_grid();
    const int lo = a.ph_lo, hi = a.ph_hi;
    unsigned char* ws = a.ws;
    const int G = gridDim.x;
    XcdBarrier xbar; xbar.bar = (unsigned*)(ws + WS_BAR); xbar.x = 0; xbar.st = (volatile LAS unsigned*)((LAS unsigned char*)lds + 131072);
    if (hi - lo > 1) {
        if (threadIdx.x < 4) ((LAS unsigned*)((LAS unsigned char*)lds + 131072))[threadIdx.x] = 0u;
        if (blockIdx.x == 0) for (int i_ = threadIdx.x; i_ < XCD_BAR_WORDS; i_ += 512) ((unsigned*)(ws + WS_BAR))[i_] = 0u;
        __syncthreads();
    }
#define IN(k) (lo <= (k) && (k) < hi)
#define PH(k, ...) do { if (IN(k)) { __VA_ARGS__; if ((REPEAT_MASK >> (k)) & 1) { grid.sync(); __VA_ARGS__; } } if (IN(k) && IN((k) + 1)) { if ((k) == 0) { grid.sync(); xbar = xcd_barrier_post((unsigned*)(ws + WS_BAR), (volatile LAS unsigned*)((LAS unsigned char*)lds + 131072)); } else xcd_barrier(xbar); } } while (0)
    PH(0, p_prep(a, lds));
    PH(1, p_h(a));
    PH(2, {
        pg8::Gemm g{(const bf16_t*)(ws + WS_AO), (const bf16_t*)(ws + WS_WIN), T, 5376, 1024}; pg8::StaticOrder S; S.init(T, 5376, G, (int)blockIdx.x);
        EpiProj E{(bf16_t*)(ws + WS_ZUV), (bf16_t*)(ws + WS_QKV), (bf16_t*)(ws + WS_GATES)};
        pg8::gemm_phase((LAS unsigned char*)lds, g, S, E); });
    PH(3, { p_gmlp(a, lds); __syncthreads(); p_attn(a, lds); });
    PH(4, {
        pg8::Gemm g{(const bf16_t*)(ws + WS_AO), (const bf16_t*)(ws + WS_WAB), 2 * T, 2048, 1024}; pg8::PairOrder S; S.so.init(T, 1024, G, (int)blockIdx.x);
        EpiMerge E{(const bf16_t*)(ws + WS_GATES), (bf16_t*)(ws + WS_QKV)};
        pg8::gemm_phase((LAS unsigned char*)lds, g, S, E); });
    PH(5, {
        pg8::Gemm g{(const bf16_t*)(ws + WS_QKV), (const bf16_t*)(ws + WS_WOUT), T, 1024, 1024}; pg8::StaticOrder S; S.init(T, 1024, G, (int)blockIdx.x);
        EpiY1 E{a.in[0], (const float*)(ws + WS_MOD), (bf16_t*)(ws + WS_ZUV)};
        pg8::gemm_phase((LAS unsigned char*)lds, g, S, E); });
    PH(6, p_ln1(a));
    PH(7, {
        pg8::Gemm g{(const bf16_t*)(ws + WS_QKV), (const bf16_t*)(ws + WS_WPQ), T, 2048, 1024}; pg8::StaticOrder S; S.init(T, 2048, G, (int)blockIdx.x);
        EpiQ E{(bf16_t*)(ws + WS_GATES)};
        pg8::gemm_phase((LAS unsigned char*)lds, g, S, E); });
    PH(8, p_topk(a, lds));
    PH(9, p_gdot(a));
    PH(10, p_gather(a));
#undef IN
#undef PH
}

extern "C" void kernel_launch(void* const* d_in, const int* in_sizes, int n_in, void* d_out, int out_size, void* d_ws, size_t ws_size, hipStream_t stream) {
    static int grid = 0;
    if (grid == 0) {
        if (n_in != 22 || ws_size < WS_END) { fprintf(stderr, "kernel_launch: unexpected n_in %d or ws_size %zu (< %zu)\n", n_in, ws_size, (size_t)WS_END); grid = -1; return; }
        int dev = 0, cus = 0, per_cu = 0;
        (void)hipGetDevice(&dev); (void)hipDeviceGetAttribute(&cus, hipDeviceAttributeMultiprocessorCount, dev);
        if (hipFuncSetAttribute((const void*)mega, hipFuncAttributeMaxDynamicSharedMemorySize, LDS_BYTES) != hipSuccess) { fprintf(stderr, "kernel_launch: hipFuncSetAttribute failed\n"); grid = -1; return; }
        if (hipOccupancyMaxActiveBlocksPerMultiprocessor(&per_cu, (const void*)mega, 512, LDS_BYTES) != hipSuccess || per_cu < 1) { fprintf(stderr, "kernel_launch: occupancy query says %d\n", per_cu); per_cu = 1; }
        (void)hipGetLastError();
        grid = cus > 0 ? cus : 256;
    }
    if (grid < 0) return;
    Args a{};
    for (int i = 0; i < 22; ++i) a.in[i] = (const float*)d_in[i];
    a.out = (float*)d_out; a.ws = (unsigned char*)d_ws;
#if ONE_LAUNCH
    a.ph_lo = 0; a.ph_hi = NPHASE;
    void* args[] = {&a};
    hipError_t e = hipLaunchCooperativeKernel((const void*)mega, dim3(grid), dim3(512), args, LDS_BYTES, stream);
    if (e != hipSuccess) fprintf(stderr, "cooperative launch failed: %s (grid %d)\n", hipGetErrorString(e), grid);
#else
    for (int p = 0; p < NPHASE; ++p) { a.ph_lo = p; a.ph_hi = p + 1; hipLaunchKernelGGL(mega, dim3(grid), dim3(512), LDS_BYTES, stream, a); }
#endif
}
```
